# Optimizing an MI355X kernel written in HIP

```python
import jax, jax.numpy as jnp
from jax import lax
import numpy as np

D_MODEL = 1024
BATCH = 8
SEQ = 2048
DEPTH = 4
DEC_BATCH = 2
DEC_SEQ = 8192
PAST_LEN = 128

GRID_W = 64
N_MIXERS = 3
N_LAYERS_A = (DEPTH + 2) // 3
N_LAYERS_B = (DEPTH + 1) // 3
N_LAYERS_C = DEPTH // 3
Q_BLOCK = 128
ROPE_THETA = 10000.0
EPS = 1e-6

MLA_HEADS = 8
MLA_Q_LORA = 384
MLA_KV_LORA = 256
MLA_NOPE = 128
MLA_ROPE = 64
MLA_V = 128

GQA_Q_HEADS = 8
GQA_KV_HEADS = 2
GQA_HEAD_DIM = 128

NA_HEADS = 16
NA_HEAD_DIM = 64
NA_WIN_ROWS_MAX = 8
NA_WIN_COLS = 16
NA_REL_ROWS = 2 * NA_WIN_ROWS_MAX - 1
NA_REL_COLS = 2 * NA_WIN_COLS - 1

D_FF = 4096
CONV_WIDTH = 3
PLE_DIM = 256

kernel_name = "hybrid_mla_gqa_natten_encoder"


def rms_norm(x, g):
    xf = x.astype(jnp.float32)
    y = xf * lax.rsqrt(jnp.mean(xf * xf, axis=-1, keepdims=True) + EPS)
    return (y * g.astype(jnp.float32)).astype(x.dtype)


def rms_norm_plain(x):
    xf = x.astype(jnp.float32)
    return (xf * lax.rsqrt(jnp.mean(xf * xf, axis=-1, keepdims=True) + EPS)).astype(x.dtype)


def rope_tables(pos, dim):
    inv = 1.0 / (ROPE_THETA ** (jnp.arange(0, dim, 2, dtype=jnp.float32) / dim))
    ang = pos.astype(jnp.float32)[:, None] * inv[None, :]
    return jnp.cos(ang), jnp.sin(ang)


def apply_rope(x, cos, sin):
    half = x.shape[-1] // 2
    x1, x2 = x[..., :half], x[..., half:]
    c = cos.astype(x.dtype)
    s = sin.astype(x.dtype)
    return jnp.concatenate([x1 * c - x2 * s, x2 * c + x1 * s], axis=-1)


def to_blocks(x, qb):
    b, s = x.shape[:2]
    return jnp.moveaxis(x.reshape((b, s // qb, qb) + x.shape[2:]), 1, 0)


def from_blocks(y):
    nb, b, qb = y.shape[:3]
    return jnp.moveaxis(y, 0, 1).reshape((b, nb * qb) + y.shape[3:])


def mla_mixer(x, w_down, q_norm, kv_norm, w_uq, w_ukv, w_o):
    b, s, _ = x.shape
    down = x @ w_down
    cq = rms_norm(down[..., :MLA_Q_LORA], q_norm)
    ckv = rms_norm(down[..., MLA_Q_LORA:MLA_Q_LORA + MLA_KV_LORA], kv_norm)
    k_rope = down[..., MLA_Q_LORA + MLA_KV_LORA:]
    q = (cq @ w_uq).reshape(b, s, MLA_HEADS, MLA_NOPE + MLA_ROPE)
    kv = (ckv @ w_ukv).reshape(b, s, MLA_HEADS, MLA_NOPE + MLA_V)
    cos, sin = rope_tables(jnp.arange(s), MLA_ROPE)
    scale = (MLA_NOPE + MLA_ROPE) ** -0.5
    q_nope = q[..., :MLA_NOPE] * scale
    q_rope = apply_rope(q[..., MLA_NOPE:], cos[:, None], sin[:, None]) * scale
    k_nope = kv[..., :MLA_NOPE]
    v = kv[..., MLA_NOPE:]
    k_rope = apply_rope(k_rope, cos, sin)

    def attend(qs):
        qn, qr = qs
        sc = (jnp.einsum('bqhd,bkhd->bhqk', qn, k_nope, preferred_element_type=jnp.float32)
              + jnp.einsum('bqhr,bkr->bhqk', qr, k_rope, preferred_element_type=jnp.float32))
        pr = jax.nn.softmax(sc, axis=-1).astype(v.dtype)
        return jnp.einsum('bhqk,bkhd->bqhd', pr, v)

    o = from_blocks(lax.map(attend, (to_blocks(q_nope, Q_BLOCK), to_blocks(q_rope, Q_BLOCK))))
    return o.reshape(b, s, MLA_HEADS * MLA_V) @ w_o


def gqa_mixer(x, w_qkv, q_norm, k_norm, w_o):
    b, s, _ = x.shape
    hd = GQA_HEAD_DIM
    qkv = x @ w_qkv
    q = qkv[..., :GQA_Q_HEADS * hd].reshape(b, s, GQA_Q_HEADS, hd)
    k = qkv[..., GQA_Q_HEADS * hd:(GQA_Q_HEADS + GQA_KV_HEADS) * hd].reshape(b, s, GQA_KV_HEADS, hd)
    v = qkv[..., (GQA_Q_HEADS + GQA_KV_HEADS) * hd:].reshape(b, s, GQA_KV_HEADS, hd)
    q = rms_norm(q, q_norm)
    k = rms_norm(k, k_norm)
    t = jnp.arange(s)
    half = hd // 2
    rc, rs = rope_tables(t // GRID_W, half)
    cc, cs = rope_tables(t % GRID_W, half)

    def axial(z):
        return jnp.concatenate([apply_rope(z[..., :half], rc[:, None], rs[:, None]),
                                apply_rope(z[..., half:], cc[:, None], cs[:, None])], axis=-1)

    q = axial(q) * hd ** -0.5
    k = axial(k)
    g = GQA_Q_HEADS // GQA_KV_HEADS
    q = q.reshape(b, s, GQA_KV_HEADS, g, hd)

    def attend(qb):
        sc = jnp.einsum('bqkgd,bskd->bkgqs', qb, k, preferred_element_type=jnp.float32)
        pr = jax.nn.softmax(sc, axis=-1).astype(v.dtype)
        return jnp.einsum('bkgqs,bskd->bqkgd', pr, v)

    o = from_blocks(lax.map(attend, to_blocks(q, Q_BLOCK)))
    return o.reshape(b, s, GQA_Q_HEADS * hd) @ w_o


def na_indices(s):
    rows = s // GRID_W
    wr = min(NA_WIN_ROWS_MAX, rows)
    wc = NA_WIN_COLS
    t = np.arange(s)
    r = t // GRID_W
    c = t % GRID_W
    r0 = np.clip(r - wr // 2, 0, rows - wr)
    c0 = np.clip(c - wc // 2, 0, GRID_W - wc)
    kr = r0[:, None] + np.arange(wr)[None, :]
    kc = c0[:, None] + np.arange(wc)[None, :]
    idx = (kr[:, :, None] * GRID_W + kc[:, None, :]).reshape(s, wr * wc)
    rel = (((kr - r[:, None] + NA_WIN_ROWS_MAX - 1)[:, :, None] * NA_REL_COLS)
           + (kc - c[:, None] + NA_WIN_COLS - 1)[:, None, :]).reshape(s, wr * wc)
    return jnp.asarray(idx, dtype=jnp.int32), jnp.asarray(rel, dtype=jnp.int32)


def na_mixer(x, w_qkv, rpb, w_o):
    b, s, _ = x.shape
    qkv = (x @ w_qkv).reshape(b, s, 3, NA_HEADS, NA_HEAD_DIM)
    q = qkv[:, :, 0] * NA_HEAD_DIM ** -0.5
    k = qkv[:, :, 1]
    v = qkv[:, :, 2]
    idx, rel = na_indices(s)
    bias_tab = rpb.reshape(NA_HEADS, NA_REL_ROWS * NA_REL_COLS)
    nb = s // GRID_W

    def attend(blk):
        qb, ib, rb = blk
        kb = k[:, ib]
        vb = v[:, ib]
        sc = (jnp.einsum('bqhd,bqkhd->bhqk', qb, kb, preferred_element_type=jnp.float32)
              + bias_tab[:, rb].astype(jnp.float32)[None])
        pr = jax.nn.softmax(sc, axis=-1).astype(v.dtype)
        return jnp.einsum('bhqk,bqkhd->bqhd', pr, vb)

    o = from_blocks(lax.map(attend, (to_blocks(q, GRID_W),
                                     idx.reshape(nb, GRID_W, -1),
                                     rel.reshape(nb, GRID_W, -1))))
    return o.reshape(b, s, NA_HEADS * NA_HEAD_DIM) @ w_o


def conv_ffn(x, w_in, conv_w, conv_b, w_out):
    gu = x @ w_in
    g, u = gu[..., :D_FF], gu[..., D_FF:]
    gp = jnp.pad(g, ((0, 0), (1, 1), (0, 0)))
    g = gp[:, :-2] * conv_w[0] + gp[:, 1:-1] * conv_w[1] + gp[:, 2:] * conv_w[2] + conv_b
    return (jax.nn.gelu(g, approximate=True) * u) @ w_out


def run_trunk(x, p, w):
    for i in range(DEPTH):
        kind, j = i % N_MIXERS, i // N_MIXERS
        hn = rms_norm(x, w['norm_mix_pre'][i])
        if kind == 0:
            m = mla_mixer(hn, w['mla_w_down'][j], w['mla_q_norm'][j], w['mla_kv_norm'][j],
                          w['mla_w_uq'][j], w['mla_w_ukv'][j], w['mla_w_o'][j])
        elif kind == 1:
            m = gqa_mixer(hn, w['gqa_w_qkv'][j], w['gqa_q_norm'][j], w['gqa_k_norm'][j], w['gqa_w_o'][j])
        else:
            m = na_mixer(hn, w['na_w_qkv'][j], w['na_rpb'][j], w['na_w_o'][j])
        x = x + rms_norm(m, w['norm_mix_post'][i])
        f = conv_ffn(rms_norm(x, w['norm_ffn_pre'][i]), w['ffn_w_in'][i], w['ffn_conv_w'][i],
                     w['ffn_conv_b'][i], w['ffn_w_out'][i])
        x = x + rms_norm(f, w['norm_ffn_post'][i])
        e = p[i] @ w['ple_w_proj'][i]
        gate = jax.nn.sigmoid(rms_norm_plain(x) @ w['ple_w_gate'][i])
        x = x + rms_norm(gate * e, w['ple_norm'][i])
    return x


def setup_inputs(seed: int = 0) -> dict:
    key = jax.random.key(seed)
    ks = jax.random.split(key, 32)
    f32 = jnp.float32

    def lin(k, shape):
        return jax.random.normal(k, shape, f32) * (shape[-2] ** -0.5)

    def gain(k, shape):
        return 1.0 + 0.05 * jax.random.normal(k, shape, f32)

    d = D_MODEL
    return {
        "x_prompt": jax.random.normal(ks[0], (BATCH, SEQ, d), f32),
        "x_sample": jax.random.normal(ks[1], (DEC_BATCH, DEC_SEQ, d), f32),
        "p_prompt": jax.random.normal(ks[2], (DEPTH, BATCH, SEQ, PLE_DIM), f32),
        "p_sample": jax.random.normal(ks[3], (DEPTH, DEC_BATCH, DEC_SEQ, PLE_DIM), f32),
        "norm_mix_pre": gain(ks[4], (DEPTH, d)),
        "norm_mix_post": gain(ks[5], (DEPTH, d)),
        "norm_ffn_pre": gain(ks[6], (DEPTH, d)),
        "norm_ffn_post": gain(ks[7], (DEPTH, d)),
        "mla_w_down": lin(ks[8], (N_LAYERS_A, d, MLA_Q_LORA + MLA_KV_LORA + MLA_ROPE)),
        "mla_q_norm": gain(ks[9], (N_LAYERS_A, MLA_Q_LORA)),
        "mla_kv_norm": gain(ks[10], (N_LAYERS_A, MLA_KV_LORA)),
        "mla_w_uq": lin(ks[11], (N_LAYERS_A, MLA_Q_LORA, MLA_HEADS * (MLA_NOPE + MLA_ROPE))),
        "mla_w_ukv": lin(ks[12], (N_LAYERS_A, MLA_KV_LORA, MLA_HEADS * (MLA_NOPE + MLA_V))),
        "mla_w_o": lin(ks[13], (N_LAYERS_A, MLA_HEADS * MLA_V, d)),
        "gqa_w_qkv": lin(ks[14], (N_LAYERS_B, d, (GQA_Q_HEADS + 2 * GQA_KV_HEADS) * GQA_HEAD_DIM)),
        "gqa_q_norm": gain(ks[15], (N_LAYERS_B, GQA_HEAD_DIM)),
        "gqa_k_norm": gain(ks[16], (N_LAYERS_B, GQA_HEAD_DIM)),
        "gqa_w_o": lin(ks[17], (N_LAYERS_B, GQA_Q_HEADS * GQA_HEAD_DIM, d)),
        "na_w_qkv": lin(ks[18], (N_LAYERS_C, d, 3 * NA_HEADS * NA_HEAD_DIM)),
        "na_rpb": 0.1 * jax.random.normal(ks[19], (N_LAYERS_C, NA_HEADS, NA_REL_ROWS, NA_REL_COLS), f32),
        "na_w_o": lin(ks[20], (N_LAYERS_C, NA_HEADS * NA_HEAD_DIM, d)),
        "ffn_w_in": lin(ks[21], (DEPTH, d, 2 * D_FF)),
        "ffn_conv_w": jax.random.normal(ks[22], (DEPTH, CONV_WIDTH, D_FF), f32) * (CONV_WIDTH ** -0.5),
        "ffn_conv_b": 0.02 * jax.random.normal(ks[23], (DEPTH, D_FF), f32),
        "ffn_w_out": lin(ks[24], (DEPTH, D_FF, d)),
        "ple_w_proj": lin(ks[25], (DEPTH, PLE_DIM, d)),
        "ple_w_gate": lin(ks[26], (DEPTH, d, d)),
        "ple_norm": gain(ks[27], (DEPTH, d)),
    }


def reference(x_prompt, x_sample, p_prompt, p_sample, norm_mix_pre, norm_mix_post, norm_ffn_pre,
              norm_ffn_post, mla_w_down, mla_q_norm, mla_kv_norm, mla_w_uq, mla_w_ukv, mla_w_o,
              gqa_w_qkv, gqa_q_norm, gqa_k_norm, gqa_w_o, na_w_qkv, na_rpb, na_w_o,
              ffn_w_in, ffn_conv_w, ffn_conv_b, ffn_w_out, ple_w_proj, ple_w_gate, ple_norm):
    w = dict(norm_mix_pre=norm_mix_pre, norm_mix_post=norm_mix_post, norm_ffn_pre=norm_ffn_pre,
             norm_ffn_post=norm_ffn_post, mla_w_down=mla_w_down, mla_q_norm=mla_q_norm,
             mla_kv_norm=mla_kv_norm, mla_w_uq=mla_w_uq, mla_w_ukv=mla_w_ukv, mla_w_o=mla_w_o,
             gqa_w_qkv=gqa_w_qkv, gqa_q_norm=gqa_q_norm, gqa_k_norm=gqa_k_norm, gqa_w_o=gqa_w_o,
             na_w_qkv=na_w_qkv, na_rpb=na_rpb, na_w_o=na_w_o, ffn_w_in=ffn_w_in,
             ffn_conv_w=ffn_conv_w, ffn_conv_b=ffn_conv_b, ffn_w_out=ffn_w_out,
             ple_w_proj=ple_w_proj, ple_w_gate=ple_w_gate, ple_norm=ple_norm)
    y_prompt = run_trunk(x_prompt, p_prompt, w)
    y_sample = run_trunk(x_sample, p_sample, w)
    return (y_prompt, y_sample)
```

```cpp
#include <hip/hip_runtime.h>
#include <hip/hip_cooperative_groups.h>
#include <cstdio>
#include <cstdint>
#include <cmath>
namespace cg = cooperative_groups;
#ifndef EN_ALL
#define EN_ALL 1
#endif
#ifndef EN_GEMM
#define EN_GEMM EN_ALL
#endif
#ifndef EN_ROW
#define EN_ROW EN_ALL
#endif
#ifndef EN_ACT
#define EN_ACT EN_ALL
#endif
#ifndef EN_MLAC
#define EN_MLAC EN_ALL
#endif
#ifndef EN_GQAC
#define EN_GQAC EN_ALL
#endif
#ifndef EN_AMLA
#define EN_AMLA EN_ALL
#endif
#ifndef EN_AGQA
#define EN_AGQA EN_ALL
#endif
#ifndef EN_NA
#define EN_NA EN_ALL
#endif
#ifndef EN_INIT
#define EN_INIT EN_ALL
#endif

#define LAS __attribute__((address_space(3)))
typedef unsigned short bf16_t;
typedef short bf16x8 __attribute__((ext_vector_type(8)));
typedef short s16x4 __attribute__((ext_vector_type(4)));
typedef float f32x4 __attribute__((ext_vector_type(4)));
typedef float f32x16 __attribute__((ext_vector_type(16)));
typedef float f32x2_t __attribute__((ext_vector_type(2)));
typedef __bf16 bf16x2_t __attribute__((ext_vector_type(2)));
typedef unsigned u32x4 __attribute__((ext_vector_type(4)));
typedef unsigned u32x2 __attribute__((ext_vector_type(2)));

constexpr int NTOK = 32768, HTOK = 16384, DM = 1024, FF = 4096, PLE = 256;
constexpr float EPS = 1e-6f;
constexpr size_t MiB = 1u << 20;
constexpr size_t WS_COS = 1 * MiB, WS_SIN = 2 * MiB, WS_WB = 4 * MiB, WS_PB = 40 * MiB, WS_HN = 56 * MiB, WS_R = 120 * MiB, WS_E = 412 * MiB, WS_END = 476 * MiB;
constexpr size_t WB_IN = 0, WB_OUT = 16 * MiB, WB_GATE = 24 * MiB, WB_PROJ = 26 * MiB, WB_MIX1 = 27 * MiB, WB_UQ = 29 * MiB, WB_UKV = 31 * MiB, WB_O = 34 * MiB;
constexpr size_t R_Q = 0, R_KV = 96 * MiB, R_DOWN = 96 * MiB, R_O = 224 * MiB, R_CQ = 224 * MiB, R_CKV = 248 * MiB, R_KROPE = 288 * MiB, R_GU = 0, R_E = 0, R_GE = 64 * MiB;
constexpr int LDS_BYTES = 148480, LDS_MISC = 148000;

__device__ __forceinline__ unsigned pk2(float lo, float hi) { f32x2_t v = {lo, hi}; bf16x2_t b = __builtin_convertvector(v, bf16x2_t); return __builtin_bit_cast(unsigned, b); }
__device__ __forceinline__ float bflo(unsigned u) { return __uint_as_float(u << 16); }
__device__ __forceinline__ float bfhi(unsigned u) { return __uint_as_float(u & 0xffff0000u); }
__device__ __forceinline__ float wave_sum(float v) {
#pragma unroll
    for (int o = 1; o < 64; o <<= 1) v += __shfl_xor(v, o);
    return v;
}
__device__ __forceinline__ float fast_sigmoid(float z) { return __builtin_amdgcn_rcpf(1.0f + __builtin_amdgcn_exp2f(-1.4426950408889634f * z)); }
__device__ __forceinline__ float gelu_tanh(float g) { const float z = 1.5957691216057308f * (g + 0.044715f * g * g * g); return g * fast_sigmoid(z); }

namespace pg8 {
constexpr int BM = 256, BK = 64, HALF = 128, HTB = HALF * BK * 2, STAGE_BYTES = 8 * HTB, NXCD = 8, WGM = 8;
__device__ __forceinline__ int lds_byte(int r, int c) { const int st = (r >> 4) * 2 + (c >> 5), rr = r & 15, cc = c & 31, ob = rr * 64 + cc * 2; return st * 1024 + (ob ^ (((ob >> 9) & 1) << 5)); }
__device__ __forceinline__ void stage_rc(int b, int& R, int& C) { const int st = b / 1024, sb = b % 1024, swz = sb ^ (((sb >> 9) & 1) << 5); R = (st >> 1) * 16 + swz / 64; C = (st & 1) * 32 + (swz % 64) / 2; }
__device__ __forceinline__ int perm32(int rho) { const int n = rho >> 4, i = rho & 15; return 8 * (i >> 2) + 4 * n + (i & 3); }
struct Unit { int pm, pn; };
struct Gemm { const bf16_t* A; const bf16_t* Bt; int M, N, K, lda, ffn; };
__device__ __forceinline__ void ffn_tile(int pm, int& tok0) { tok0 = 254 * pm - 1; }
__device__ __forceinline__ long a_row0(const Gemm& g, int pm) { if (!g.ffn) return (long)pm * BM; int tok0; ffn_tile(pm, tok0); return (long)tok0; }
struct StaticOrder {
    int nM, nN, nwg, G, c;
    __device__ __forceinline__ void init(int M, int N, int G_, int c_) { nM = M / BM; nN = N / BM; nwg = nM * nN; G = G_; c = c_; }
    __device__ __forceinline__ bool next(int i, Unit& u) const {
        const long L = (long)i * G + c; if (L >= nwg) return false;
        int wgid = (int)L; { const int q = nwg / NXCD, r = nwg % NXCD, xcd = wgid % NXCD, off = wgid / NXCD; wgid = (xcd < r ? xcd * (q + 1) : r * (q + 1) + (xcd - r) * q) + off; }
        const int nig = WGM * nN, gid = wgid / nig, fm = gid * WGM, gsz = (nM - fm) < WGM ? (nM - fm) : WGM;
        u.pm = fm + ((wgid % nig) % gsz); u.pn = (wgid % nig) / gsz; return true;
    }
};
struct Epi {
    bf16_t* O; int ldc; const bf16_t* E; int mode; const float* cw; const float* cb; LAS float* xl;
    __device__ __forceinline__ void ffn(const f32x4 (&acc)[2][2][4][2], const Unit& u, int wr, int wc, int fr, int fq, int lane) const {
        int tok0; ffn_tile(u.pm, tok0);
        const int colw = wc * 32 + 8 * fq;
        const int gcol = u.pn * 128 + colw;
        f32x4 w0[2], w1[2], w2[2], bb[2];
#pragma unroll
        for (int n = 0; n < 2; ++n) { w0[n] = *(const f32x4*)(cw + gcol + 4 * n); w1[n] = *(const f32x4*)(cw + 4096 + gcol + 4 * n); w2[n] = *(const f32x4*)(cw + 8192 + gcol + 4 * n); bb[n] = *(const f32x4*)(cb + gcol + 4 * n); }
#pragma unroll
        for (int ai = 0; ai < 2; ++ai) { const int c = 2 * ai + wr;
            if (fr == 0) { *(LAS f32x4*)(xl + (c * 2 + 0) * 128 + colw) = acc[ai][0][0][0]; *(LAS f32x4*)(xl + (c * 2 + 0) * 128 + colw + 4) = acc[ai][0][0][1]; }
            if (fr == 15) { *(LAS f32x4*)(xl + (c * 2 + 1) * 128 + colw) = acc[ai][0][3][0]; *(LAS f32x4*)(xl + (c * 2 + 1) * 128 + colw + 4) = acc[ai][0][3][1]; } }
        asm volatile("s_waitcnt lgkmcnt(0)" ::: "memory"); __builtin_amdgcn_s_barrier(); asm volatile("" ::: "memory");
        const int sl_up = (lane & 48) | ((fr + 15) & 15), sl_dn = (lane & 48) | ((fr + 1) & 15);
#pragma unroll
        for (int ai = 0; ai < 2; ++ai) { const int c = 2 * ai + wr;
            f32x4 xup[2], xdn[2];
#pragma unroll
            for (int n = 0; n < 2; ++n) { xup[n] = c > 0 ? *(const LAS f32x4*)(xl + ((c - 1) * 2 + 1) * 128 + colw + 4 * n) : (f32x4){0.f, 0.f, 0.f, 0.f};
                                          xdn[n] = c < 3 ? *(const LAS f32x4*)(xl + ((c + 1) * 2 + 0) * 128 + colw + 4 * n) : (f32x4){0.f, 0.f, 0.f, 0.f}; }
#pragma unroll
            for (int m = 0; m < 4; ++m) {
                const int lr = 128 * ai + 64 * wr + 16 * m + fr, tok = tok0 + lr, Lm = tok < HTOK ? 2047 : 8191, pos = tok & Lm;
                u32x4 w;
#pragma unroll
                for (int n = 0; n < 2; ++n) {
                    f32x4 up, dn; const f32x4 cur = acc[ai][0][m][n];
#pragma unroll
                    for (int e = 0; e < 4; ++e) {
                        const float su = (fr == 15 && m > 0) ? acc[ai][0][m > 0 ? m - 1 : 0][n][e] : cur[e];
                        const float sd = (fr == 0 && m < 3) ? acc[ai][0][m < 3 ? m + 1 : 3][n][e] : cur[e];
                        up[e] = __shfl(su, sl_up); dn[e] = __shfl(sd, sl_dn);
                    }
                    if (m == 0 && fr == 0) up = xup[n];
                    if (m == 3 && fr == 15) dn = xdn[n];
                    if (pos == 0) up = (f32x4){0.f, 0.f, 0.f, 0.f};
                    if (pos == Lm) dn = (f32x4){0.f, 0.f, 0.f, 0.f};
                    const f32x4 g = w0[n] * up + w1[n] * cur + w2[n] * dn + bb[n]; const f32x4 uu = acc[ai][1][m][n];
                    const float r0 = gelu_tanh(g[0]) * uu[0], r1 = gelu_tanh(g[1]) * uu[1], r2 = gelu_tanh(g[2]) * uu[2], r3 = gelu_tanh(g[3]) * uu[3];
                    if (n == 0) { w.x = pk2(r0, r1); w.y = pk2(r2, r3); } else { w.z = pk2(r0, r1); w.w = pk2(r2, r3); }
                }
                { const bool ok = lr >= 1 && lr <= 254 && tok < NTOK; *(u32x4*)(O + (size_t)(ok ? tok : NTOK) * 4096 + gcol) = w; }
            }
        }
    }
    __device__ __forceinline__ void operator()(const f32x4 (&acc)[2][2][4][2], const Unit& u, int wr, int wc, int fr, int fq) const {
        const int row0 = u.pm * BM + wr * 64 + fr; const int col0 = u.pn * BM + wc * 32 + 8 * fq;
#pragma unroll
        for (int ai = 0; ai < 2; ++ai)
#pragma unroll
            for (int m = 0; m < 4; ++m) {
                const size_t ro = (size_t)(row0 + ai * HALF + m * 16) * ldc + col0;
#pragma unroll
                for (int bj = 0; bj < 2; ++bj) {
                    f32x4 v0 = acc[ai][bj][m][0], v1 = acc[ai][bj][m][1];
                    if (mode == 1) {
                        const u32x4 e = *(const u32x4*)(E + ro + bj * HALF);
                        v0[0] = fast_sigmoid(v0[0]) * bflo(e.x); v0[1] = fast_sigmoid(v0[1]) * bfhi(e.x); v0[2] = fast_sigmoid(v0[2]) * bflo(e.y); v0[3] = fast_sigmoid(v0[3]) * bfhi(e.y);
                        v1[0] = fast_sigmoid(v1[0]) * bflo(e.z); v1[1] = fast_sigmoid(v1[1]) * bfhi(e.z); v1[2] = fast_sigmoid(v1[2]) * bflo(e.w); v1[3] = fast_sigmoid(v1[3]) * bfhi(e.w);
                    }
                    u32x4 w; w.x = pk2(v0[0], v0[1]); w.y = pk2(v0[2], v0[3]); w.z = pk2(v1[0], v1[1]); w.w = pk2(v1[2], v1[3]);
                    *(u32x4*)(O + ro + bj * HALF) = w;
                }
            }
    }
};

__device__ __forceinline__ void gemm_phase(LAS unsigned char* lds, const Gemm g, const StaticOrder& S, const Epi& E, const int tid) {
    const int wid = __builtin_amdgcn_readfirstlane(tid >> 6), lane = tid & 63, wr = wid >> 2, wc = wid & 3, fr = lane & 15, fq = lane >> 4;
    const int K = g.K, nt = K / BK, lda = g.lda;
    unsigned voffA[2], voffB[2];
#pragma unroll
    for (int i = 0; i < 2; ++i) { int R, C; stage_rc(tid * 16 + i * 8192, R, C); const int Rb = (R & ~31) + perm32(R & 31);
        voffA[i] = (unsigned)(R * lda + C) * 2u; voffB[i] = (unsigned)(Rb * K + C) * 2u; }
    const size_t kstep = (size_t)(BK * 2);
    const size_t hstepA = (size_t)HALF * lda * 2, hstepB = (size_t)HALF * K * 2;
    const size_t tstepB = 2 * hstepB;
    const unsigned ldsw = (unsigned)wid * 1024u;
    const int aoff = lds_byte(wr * 64 + fr, fq * 8), boff = lds_byte(wc * 32 + fr, fq * 8);
#define PG8_SA(b, h) (((b) * 2 + (h)) * HTB)
#define PG8_SB(b, h) ((4 + (b) * 2 + (h)) * HTB)
#define PG8_STAGE(bufoff, gbase, voff) do { _Pragma("unroll") for (int _i = 0; _i < 2; ++_i) \
        __builtin_amdgcn_global_load_lds((const unsigned*)((const char*)(gbase) + (voff)[_i]), (LAS unsigned*)(lds + (bufoff) + ldsw + _i * 8192), 16, 0, 0); } while (0)
#define PG8_LDA(dst, b, h) do { _Pragma("unroll") for (int m = 0; m < 4; ++m) _Pragma("unroll") for (int k = 0; k < 2; ++k) dst[m][k] = *(const LAS bf16x8*)(lds + PG8_SA(b, h) + aoff + m * 2048 + k * 1024); } while (0)
#define PG8_LDB(dst, b, h) do { _Pragma("unroll") for (int n = 0; n < 2; ++n) _Pragma("unroll") for (int k = 0; k < 2; ++k) dst[n][k] = *(const LAS bf16x8*)(lds + PG8_SB(b, h) + boff + n * 2048 + k * 1024); } while (0)
#define PG8_MMA(ai, bj, At, Bt) do { __builtin_amdgcn_s_setprio(1); _Pragma("unroll") for (int m = 0; m < 4; ++m) _Pragma("unroll") for (int n = 0; n < 2; ++n) _Pragma("unroll") for (int k = 0; k < 2; ++k) \
        acc[ai][bj][m][n] = __builtin_amdgcn_mfma_f32_16x16x32_bf16(Bt[n][k], At[m][k], acc[ai][bj][m][n], 0, 0, 0); __builtin_amdgcn_s_setprio(0); } while (0)
#define PG8_WAIT_V(n) asm volatile("s_waitcnt vmcnt(" #n ")" ::: "memory")
#define PG8_WAIT_L(n) asm volatile("s_waitcnt lgkmcnt(" #n ")" ::: "memory")
#define PG8_BAR __builtin_amdgcn_s_barrier()
#define PG8_SCHED __builtin_amdgcn_sched_barrier(0)
    Unit cur, nxt; int ui = 0;
    if (!S.next(0, cur)) return;
    f32x4 acc[2][2][4][2];
#pragma unroll
    for (int a = 0; a < 2; ++a)
#pragma unroll
        for (int b = 0; b < 2; ++b)
#pragma unroll
            for (int m = 0; m < 4; ++m)
#pragma unroll
                for (int n = 0; n < 2; ++n) acc[a][b][m][n] = (f32x4){0.f, 0.f, 0.f, 0.f};
    bf16x8 At[4][2], B0[2][2], B1[2][2];
    const long rowbA = (long)lda * 2;
    const char* cA = (const char*)g.A + a_row0(g, cur.pm) * rowbA; const char* cB = (const char*)g.Bt + (size_t)cur.pn * tstepB;
    PG8_STAGE(PG8_SB(0, 0), cB, voffB); PG8_STAGE(PG8_SB(0, 1), cB + hstepB, voffB); PG8_STAGE(PG8_SA(0, 0), cA, voffA); PG8_STAGE(PG8_SA(0, 1), cA + hstepA, voffA);
    if (wr == 1) PG8_BAR;
    PG8_WAIT_V(2); PG8_BAR;
    PG8_STAGE(PG8_SB(1, 0), cB + kstep, voffB); PG8_STAGE(PG8_SA(1, 0), cA + kstep, voffA); PG8_STAGE(PG8_SB(1, 1), cB + hstepB + kstep, voffB);
    PG8_WAIT_V(6); PG8_BAR;
    for (;;) {
        const bool has_next = S.next(ui + 1, nxt);
        const char* nA = has_next ? (const char*)g.A + a_row0(g, nxt.pm) * rowbA : cA; const char* nB = has_next ? (const char*)g.Bt + (size_t)nxt.pn * tstepB : cB;
        for (int t = 0; t < nt; t += 2) {
            const bool last = (t == nt - 2);
            const char* a1 = cA + (size_t)(t + 1) * kstep;
            const char* a2 = last ? nA : cA + (size_t)(t + 2) * kstep; const char* b2 = last ? nB : cB + (size_t)(t + 2) * kstep;
            const char* a3 = a2 + kstep; const char* b3 = b2 + kstep;
            PG8_LDB(B0, 0, 0); PG8_LDB(B1, 0, 1); PG8_SCHED; PG8_LDA(At, 0, 0); PG8_STAGE(PG8_SA(1, 1), a1 + hstepA, voffA);
            PG8_WAIT_V(8); PG8_WAIT_L(0); PG8_BAR; PG8_MMA(0, 0, At, B0); PG8_MMA(0, 1, At, B1); PG8_BAR; PG8_SCHED;
            PG8_LDA(At, 0, 1); PG8_STAGE(PG8_SB(0, 0), b2, voffB); PG8_STAGE(PG8_SB(0, 1), b2 + hstepB, voffB); PG8_STAGE(PG8_SA(0, 0), a2, voffA);
            PG8_WAIT_V(8); PG8_WAIT_L(0); PG8_BAR; PG8_MMA(1, 0, At, B0); PG8_MMA(1, 1, At, B1); PG8_BAR; PG8_SCHED;
            PG8_LDB(B0, 1, 0); PG8_LDB(B1, 1, 1); PG8_SCHED; PG8_LDA(At, 1, 0); PG8_STAGE(PG8_SA(0, 1), a2 + hstepA, voffA);
            PG8_WAIT_V(8); PG8_WAIT_L(0); PG8_BAR; PG8_MMA(0, 0, At, B0); PG8_MMA(0, 1, At, B1); PG8_BAR; PG8_SCHED;
            PG8_LDA(At, 1, 1); PG8_STAGE(PG8_SB(1, 0), b3, voffB); PG8_STAGE(PG8_SB(1, 1), b3 + hstepB, voffB); PG8_STAGE(PG8_SA(1, 0), a3, voffA);
            PG8_WAIT_V(8); PG8_WAIT_L(0); PG8_BAR; PG8_MMA(1, 0, At, B0); PG8_MMA(1, 1, At, B1); PG8_BAR; PG8_SCHED;
        }
        if (wr == 0) PG8_BAR;
        if (E.mode == 2) E.ffn(acc, cur, wr, wc, fr, fq, lane); else E(acc, cur, wr, wc, fr, fq);
        if (!has_next) break;
#pragma unroll
        for (int a = 0; a < 2; ++a)
#pragma unroll
            for (int b = 0; b < 2; ++b)
#pragma unroll
                for (int m = 0; m < 4; ++m)
#pragma unroll
                    for (int n = 0; n < 2; ++n) acc[a][b][m][n] = (f32x4){0.f, 0.f, 0.f, 0.f};
        cur = nxt; cA = nA; cB = nB; ++ui;
        if (wr == 1) PG8_BAR;
    }
    PG8_WAIT_V(0);
    PG8_BAR;
#undef PG8_SA
#undef PG8_SB
#undef PG8_STAGE
#undef PG8_LDA
#undef PG8_LDB
#undef PG8_MMA
#undef PG8_WAIT_V
#undef PG8_WAIT_L
#undef PG8_BAR
#undef PG8_SCHED
}
}

namespace att {
constexpr int NW = 8, QBLK = 32, KVBLK = 64;
constexpr int LDQ = 1536, LDO = 1024;
constexpr int SHM_V = KVBLK * 128 * 2, SHM_K = KVBLK * 272, SHM_KR = KVBLK * 144;
constexpr int OFF_K = 2 * SHM_V, OFF_KR = OFF_K + 2 * SHM_K, OFF_WS = OFF_KR + 2 * SHM_KR, OFF_QR = OFF_WS + NW * 64 * 4, SHM_ATTN = OFF_QR + NW * 4608;
constexpr float THR = 8.f;
#define KSWZ(row, colB) ((row) * 272 + (colB))
#define KRSWZ(row, colB) ((row) * 144 + (colB))
#define SBAR() __builtin_amdgcn_sched_barrier(0)
__device__ __forceinline__ int crow(int r, int hi) { return (r & 3) + 8 * (r >> 2) + 4 * hi; }
__device__ __forceinline__ unsigned cvtpk(float lo, float hi) { return pk2(lo, hi); }

template <int DQK> __device__ __forceinline__ void partialSM(f32x16& p0, f32x16& p1, float& m_reg, float& mn, float& alpha) {
  constexpr float SCALE = (DQK == 192) ? 0.07216878364870322f : (DQK == 64 ? 1.0f : 0.08838834764831845f);
  constexpr float C = SCALE * 1.4426950408889634f;
  float pmax = p0[0];
#pragma unroll
  for (int r = 1; r < 16; ++r) pmax = fmaxf(pmax, p0[r]);
#pragma unroll
  for (int r = 0; r < 16; ++r) pmax = fmaxf(pmax, p1[r]);
  { auto rr = __builtin_amdgcn_permlane32_swap(__float_as_uint(pmax), __float_as_uint(pmax), false, false);
    pmax = fmaxf(__uint_as_float(rr[0]), __uint_as_float(rr[1])); }
  if (__builtin_expect(__all(pmax - m_reg <= THR / SCALE), 1)) { mn = m_reg; alpha = 1.f; }
  else { mn = fmaxf(m_reg, pmax); alpha = __builtin_amdgcn_exp2f((m_reg - mn) * C); m_reg = mn; }
  float mnC = -mn * C;
#pragma unroll
  for (int r = 0; r < 16; ++r) p0[r] = fmaf(p0[r], C, mnC);
#pragma unroll
  for (int r = 0; r < 16; ++r) p1[r] = fmaf(p1[r], C, mnC);
#pragma unroll
  for (int r = 0; r < 16; ++r) p0[r] = __builtin_amdgcn_exp2f(p0[r]);
}
__device__ __forceinline__ void finishSM(f32x16& p0, f32x16& p1, float alpha, float& l_reg, bf16x8& pa0, bf16x8& pa1, bf16x8& pa2, bf16x8& pa3) {
#pragma unroll
  for (int r = 0; r < 16; ++r) p1[r] = __builtin_amdgcn_exp2f(p1[r]);
  float ps = 0;
#pragma unroll
  for (int r = 0; r < 16; ++r) ps += p0[r];
#pragma unroll
  for (int r = 0; r < 16; ++r) ps += p1[r];
  { auto rr = __builtin_amdgcn_permlane32_swap(__float_as_uint(ps), __float_as_uint(ps), false, false);
    ps = __uint_as_float(rr[0]) + __uint_as_float(rr[1]); }
  l_reg = l_reg * alpha + ps;
#define PK4(P, BASE, OUT) do { unsigned a0 = cvtpk(P[BASE + 0], P[BASE + 1]), a1 = cvtpk(P[BASE + 2], P[BASE + 3]);   \
    unsigned b0 = cvtpk(P[BASE + 4], P[BASE + 5]), b1 = cvtpk(P[BASE + 6], P[BASE + 7]);                              \
    auto r0 = __builtin_amdgcn_permlane32_swap(a0, b0, false, false); auto r1 = __builtin_amdgcn_permlane32_swap(a1, b1, false, false); \
    u32x4 w = {r0[0], r1[0], r0[1], r1[1]}; OUT = *reinterpret_cast<bf16x8*>(&w); } while (0)
  PK4(p0, 0, pa0); PK4(p0, 8, pa1); PK4(p1, 0, pa2); PK4(p1, 8, pa3);
#undef PK4
}
template <int DQK> __device__ __forceinline__ void qkt(f32x16& p0, f32x16& p1, const bf16_t* Ks, const char* KRs, const char* QRw, const bf16x8* qr, int r32, int hi) {
  p0 = f32x16{}; p1 = f32x16{};
#pragma unroll
  for (int d0 = 0; d0 < 8; ++d0) { int cb = (d0 * 16 + hi * 8) * 2;
    bf16x8 b0 = *reinterpret_cast<const bf16x8*>((const char*)Ks + KSWZ(r32, cb));
    bf16x8 b1 = *reinterpret_cast<const bf16x8*>((const char*)Ks + KSWZ(32 + r32, cb));
    p0 = __builtin_amdgcn_mfma_f32_32x32x16_bf16(b0, qr[d0], p0, 0, 0, 0);
    p1 = __builtin_amdgcn_mfma_f32_32x32x16_bf16(b1, qr[d0], p1, 0, 0, 0); }
  if constexpr (DQK == 192) {
#pragma unroll
    for (int d0 = 0; d0 < 4; ++d0) { int cb = (d0 * 16 + hi * 8) * 2;
      bf16x8 b0 = *reinterpret_cast<const bf16x8*>(KRs + KRSWZ(r32, cb));
      bf16x8 b1 = *reinterpret_cast<const bf16x8*>(KRs + KRSWZ(32 + r32, cb));
      bf16x8 qx = *reinterpret_cast<const bf16x8*>(QRw + KRSWZ(r32, cb));
      p0 = __builtin_amdgcn_mfma_f32_32x32x16_bf16(b0, qx, p0, 0, 0, 0);
      p1 = __builtin_amdgcn_mfma_f32_32x32x16_bf16(b1, qx, p1, 0, 0, 0); }
  }
}
__device__ __forceinline__ int v_st(int k, int c) { const int kk = (k & ~0xC) | ((k & 4) << 1) | ((k & 8) >> 1); return ((kk >> 3) * 4 + (c >> 5)) * 512 + ((kk & 7) * 32 + (c & 31)) * 2; }
__device__ __forceinline__ int v_rd_base(int lane) { return ((lane & 3) << 3) | (((lane >> 2) & 3) << 6) | (((lane >> 4) & 1) << 5) | (((lane >> 5) & 1) << 8); }
constexpr int v_rd_off(int d0, int ks, int half) { return d0 * 512 + ks * 4096 + half * 2048; }
template <int OFF> __device__ __forceinline__ s16x4 tr_read(int vb) {
  s16x4 r; asm volatile("ds_read_b64_tr_b16 %0, %1 offset:%2" : "=&v"(r) : "v"(vb), "i"(OFF) : "memory"); return r;
}
template <int D0> __device__ __forceinline__ void pv_one(f32x16& od, int vb, bf16x8 pa0, bf16x8 pa1, bf16x8 pa2, bf16x8 pa3) {
  const s16x4 l0 = tr_read<v_rd_off(D0, 0, 0)>(vb), h0 = tr_read<v_rd_off(D0, 0, 1)>(vb), l1 = tr_read<v_rd_off(D0, 1, 0)>(vb), h1 = tr_read<v_rd_off(D0, 1, 1)>(vb);
  const s16x4 l2 = tr_read<v_rd_off(D0, 2, 0)>(vb), h2 = tr_read<v_rd_off(D0, 2, 1)>(vb), l3 = tr_read<v_rd_off(D0, 3, 0)>(vb), h3 = tr_read<v_rd_off(D0, 3, 1)>(vb);
  asm volatile("s_waitcnt lgkmcnt(0)" ::: "memory"); SBAR();
#define PK(L, H) (bf16x8){L[0], L[1], L[2], L[3], H[0], H[1], H[2], H[3]}
  od = __builtin_amdgcn_mfma_f32_32x32x16_bf16(pa0, PK(l0, h0), od, 0, 0, 0);
  od = __builtin_amdgcn_mfma_f32_32x32x16_bf16(pa1, PK(l1, h1), od, 0, 0, 0);
  od = __builtin_amdgcn_mfma_f32_32x32x16_bf16(pa2, PK(l2, h2), od, 0, 0, 0);
  od = __builtin_amdgcn_mfma_f32_32x32x16_bf16(pa3, PK(l3, h3), od, 0, 0, 0);
#undef PK
}
__device__ __forceinline__ void pv_d0(f32x16* o, int vb, bf16x8 pa0, bf16x8 pa1, bf16x8 pa2, bf16x8 pa3) {
  pv_one<0>(o[0], vb, pa0, pa1, pa2, pa3); pv_one<1>(o[1], vb, pa0, pa1, pa2, pa3); pv_one<2>(o[2], vb, pa0, pa1, pa2, pa3); pv_one<3>(o[3], vb, pa0, pa1, pa2, pa3);
}


template <int DQK> __device__ __forceinline__ void pv_partialSM(f32x16* o, int vb, bf16x8 pa0, bf16x8 pa1, bf16x8 pa2, bf16x8 pa3,
                                                                 f32x16& p0, f32x16& p1, float& m_reg, float& alpha) {
  constexpr float SCALE = (DQK == 192) ? 0.07216878364870322f : (DQK == 64 ? 1.0f : 0.08838834764831845f);
  constexpr float C = SCALE * 1.4426950408889634f;
  pv_one<0>(o[0], vb, pa0, pa1, pa2, pa3);
  float pmax = p0[0];
#pragma unroll
  for (int r = 1; r < 16; ++r) pmax = fmaxf(pmax, p0[r]);
  pv_one<1>(o[1], vb, pa0, pa1, pa2, pa3);
#pragma unroll
  for (int r = 0; r < 16; ++r) pmax = fmaxf(pmax, p1[r]);
  { auto rr = __builtin_amdgcn_permlane32_swap(__float_as_uint(pmax), __float_as_uint(pmax), false, false);
    pmax = fmaxf(__uint_as_float(rr[0]), __uint_as_float(rr[1])); }
  const bool keep = __all(pmax - m_reg <= THR / SCALE);
  const float mn = keep ? m_reg : fmaxf(m_reg, pmax);
  alpha = __builtin_amdgcn_exp2f((m_reg - mn) * C); m_reg = mn;
  const float mnC = -mn * C;
  pv_one<2>(o[2], vb, pa0, pa1, pa2, pa3);
#pragma unroll
  for (int r = 0; r < 16; ++r) { p0[r] = fmaf(p0[r], C, mnC); p1[r] = fmaf(p1[r], C, mnC); }
  pv_one<3>(o[3], vb, pa0, pa1, pa2, pa3);
#pragma unroll
  for (int r = 0; r < 16; ++r) p0[r] = __builtin_amdgcn_exp2f(p0[r]);
  asm volatile("" : "+v"(p0), "+v"(p1));
  SBAR();
}

template <int DQK, int LDK>
__device__ __forceinline__ void attn_unit(const bf16_t* __restrict__ Qb, const bf16_t* __restrict__ Kh, const bf16_t* __restrict__ Vh, const bf16_t* __restrict__ Krp,
                                          bf16_t* __restrict__ Ob, int seq, int qpos0, const float* __restrict__ COS, const float* __restrict__ SIN, char* lds) {
  constexpr bool ROPE = (DQK == 192);
  constexpr int NQ = 8;
  int tid_ = threadIdx.x; asm volatile("" : "+v"(tid_));
  const int tid = tid_, wid = __builtin_amdgcn_readfirstlane(tid >> 6), lane = tid & 63, r32 = lane & 31, hi = lane >> 5;
  char* QRw = lds + OFF_QR + wid * 4608;
  bf16_t* V_lds = (bf16_t*)lds; bf16_t* K_lds = (bf16_t*)(lds + OFF_K); char* KR_lds = lds + OFF_KR;
  float* ws = (float*)(lds + OFF_WS) + wid * 64; float* li_l = ws; float* al_l = ws + 32;
  float m_reg = -1e30f, l_reg = 0; f32x16 o[4] = {}; bf16x8 qr[NQ];
  const bf16_t* Qw = Qb + (long)(wid * QBLK + r32) * LDQ + hi * 8;
#pragma unroll
  for (int d0 = 0; d0 < NQ; ++d0) qr[d0] = *reinterpret_cast<const bf16x8*>(Qw + d0 * 16);
  if constexpr (ROPE) {
    const int pos = qpos0 + wid * QBLK + r32;
#pragma unroll
    for (int d = 0; d < 2; ++d) {
      const float* cp = COS + pos * 32 + d * 16 + hi * 8; const float* sp = SIN + pos * 32 + d * 16 + hi * 8;
      const f32x4 c0 = *(const f32x4*)cp, c1 = *(const f32x4*)(cp + 4), s0 = *(const f32x4*)sp, s1 = *(const f32x4*)(sp + 4);
      const bf16x8 a = *reinterpret_cast<const bf16x8*>(Qw + (8 + d) * 16), b = *reinterpret_cast<const bf16x8*>(Qw + (10 + d) * 16);
      float y1[8], y2[8];
#pragma unroll
      for (int e = 0; e < 8; ++e) { const float c = e < 4 ? c0[e & 3] : c1[e & 3], s = e < 4 ? s0[e & 3] : s1[e & 3];
        const float x1 = __uint_as_float(((unsigned)(unsigned short)a[e]) << 16), x2 = __uint_as_float(((unsigned)(unsigned short)b[e]) << 16);
        y1[e] = x1 * c - x2 * s; y2[e] = x2 * c + x1 * s; }
      u32x4 wa = {pk2(y1[0], y1[1]), pk2(y1[2], y1[3]), pk2(y1[4], y1[5]), pk2(y1[6], y1[7])};
      u32x4 wb = {pk2(y2[0], y2[1]), pk2(y2[2], y2[3]), pk2(y2[4], y2[5]), pk2(y2[6], y2[7])};
      *(u32x4*)(QRw + KRSWZ(r32, (d * 16 + hi * 8) * 2)) = wa; *(u32x4*)(QRw + KRSWZ(r32, (32 + d * 16 + hi * 8) * 2)) = wb;
    }
  }
  const int sr = tid >> 4, sc = (tid & 15) * 8, vst0 = v_st(sr, sc), vst1 = v_st(32 + sr, sc);
  const int krr = tid >> 3, krc = (tid & 7) * 8;
  const int vb0 = (int)(uintptr_t)V_lds + v_rd_base(lane);
  constexpr int SD = ROPE ? 1 : 2;
  struct { bf16x8 vs0, vs1, ks0, ks1, kr; } sr_[SD];
#define SLOAD(i, k0) do { sr_[i].vs0 = *(const bf16x8*)(&Vh[(long)((k0) + sr) * LDK + sc]); sr_[i].vs1 = *(const bf16x8*)(&Vh[(long)((k0) + 32 + sr) * LDK + sc]); \
    sr_[i].ks0 = *(const bf16x8*)(&Kh[(long)((k0) + sr) * LDK + sc]); sr_[i].ks1 = *(const bf16x8*)(&Kh[(long)((k0) + 32 + sr) * LDK + sc]); \
    if constexpr (ROPE) sr_[i].kr = *(const bf16x8*)(&Krp[(long)((k0) + krr) * 64 + krc]); } while (0)
#define SWRITE(b, i) do { *(bf16x8*)((char*)V_lds + (b) * SHM_V + vst0) = sr_[i].vs0;          \
    *(bf16x8*)((char*)V_lds + (b) * SHM_V + vst1) = sr_[i].vs1; int kc = sc * 2;               \
    *(bf16x8*)((char*)K_lds + (b) * SHM_K + KSWZ(sr, kc)) = sr_[i].ks0;                       \
    *(bf16x8*)((char*)K_lds + (b) * SHM_K + KSWZ(32 + sr, kc)) = sr_[i].ks1;                  \
    if constexpr (ROPE) *(bf16x8*)(KR_lds + (b) * SHM_KR + KRSWZ(krr, krc * 2)) = sr_[i].kr; } while (0)
#define SWAIT() do { if constexpr (SD == 1) asm volatile("s_waitcnt vmcnt(0)" ::: "memory"); else asm volatile("s_waitcnt vmcnt(4)" ::: "memory"); } while (0)
#define RESC(a) do { if (__any((a) < 1.f)) { if (hi == 0) al_l[r32] = (a); asm volatile("s_waitcnt lgkmcnt(0)" ::: "memory"); \
    _Pragma("unroll") for (int d = 0; d < 4; ++d) _Pragma("unroll") for (int r = 0; r < 16; ++r) o[d][r] *= al_l[crow(r, hi)]; } } while (0)
  f32x16 pA0, pA1, pB0, pB1; float mnA, mnB, alA, alB; bf16x8 pa0, pa1, pa2, pa3; const int NT = seq / KVBLK;
  constexpr int SE = 0, SO = SD - 1;
  SLOAD(SE, 0); asm volatile("s_waitcnt vmcnt(0)" ::: "memory"); SWRITE(0, SE); __syncthreads();
  qkt<DQK>(pA0, pA1, K_lds, KR_lds, QRw, qr, r32, hi); partialSM<DQK>(pA0, pA1, m_reg, mnA, alA);
  SLOAD(SO, KVBLK); if constexpr (SD == 2) { if (2 < NT) SLOAD(SE, 2 * KVBLK); }
  SWAIT(); SWRITE(1, SO); __syncthreads();
  for (int j = 1; j + 1 < NT; j += 2) {
    SBAR(); qkt<DQK>(pB0, pB1, (bf16_t*)((char*)K_lds + SHM_K), KR_lds + SHM_KR, QRw, qr, r32, hi);
    finishSM(pA0, pA1, alA, l_reg, pa0, pa1, pa2, pa3); SBAR();
    SLOAD(SO, (j + SD) * KVBLK); SBAR();
    pv_partialSM<DQK>(o, vb0, pa0, pa1, pa2, pa3, pB0, pB1, m_reg, alB);
    __syncthreads(); SWAIT(); SWRITE(0, SE);
    RESC(alB); __syncthreads();
    SBAR(); qkt<DQK>(pA0, pA1, K_lds, KR_lds, QRw, qr, r32, hi);
    finishSM(pB0, pB1, alB, l_reg, pa0, pa1, pa2, pa3); SBAR();
    if (SD == 1 || j + 3 < NT) SLOAD(SE, (j + 1 + SD) * KVBLK); SBAR();
    pv_partialSM<DQK>(o, vb0 + (int)SHM_V, pa0, pa1, pa2, pa3, pA0, pA1, m_reg, alA);
    __syncthreads(); SWAIT(); SWRITE(1, SO);
    RESC(alA); __syncthreads();
  }
  SBAR(); qkt<DQK>(pB0, pB1, (bf16_t*)((char*)K_lds + SHM_K), KR_lds + SHM_KR, QRw, qr, r32, hi);
  finishSM(pA0, pA1, alA, l_reg, pa0, pa1, pa2, pa3); SBAR();
  pv_partialSM<DQK>(o, vb0, pa0, pa1, pa2, pa3, pB0, pB1, m_reg, alB);
  __syncthreads(); RESC(alB);
  finishSM(pB0, pB1, alB, l_reg, pa0, pa1, pa2, pa3); SBAR();
  pv_d0(o, vb0 + (int)SHM_V, pa0, pa1, pa2, pa3);
  if (hi == 0) li_l[r32] = l_reg; asm volatile("s_waitcnt lgkmcnt(0)" ::: "memory");
  float rli[16];
#pragma unroll
  for (int r = 0; r < 16; ++r) rli[r] = __builtin_amdgcn_rcpf(li_l[crow(r, hi)]);
  bf16_t* Ow = Ob + (long)(wid * QBLK) * LDO;
#pragma unroll
  for (int r = 0; r < 16; ++r) { int orow = crow(r, hi);
#pragma unroll
    for (int d0 = 0; d0 < 4; ++d0) Ow[(long)orow * LDO + d0 * 32 + r32] = (bf16_t)(pk2(o[d0][r] * rli[r], 0.f) & 0xffffu); }
  __syncthreads();
#undef SLOAD
#undef SWRITE
#undef SWAIT
#undef RESC
}
}

namespace na {
constexpr int KROW = 9232, KEYB = 144, VOFF = 8 * KROW;
__device__ __forceinline__ float dot2(unsigned a, unsigned b, float c) { return __builtin_amdgcn_fdot2_f32_bf16(__builtin_bit_cast(bf16x2_t, a), __builtin_bit_cast(bf16x2_t, b), c, false); }
__device__ __forceinline__ void na_unit(const bf16_t* __restrict__ QKV, bf16_t* __restrict__ O, const float* __restrict__ rpb, int tok0, int rows, int r, int h, LAS unsigned char* lds, const int tid) {
  const int r0 = min(max(r - 4, 0), rows - 8);
  const bf16_t* kbase = QKV + (size_t)(tok0 + r0 * 64) * 3072 + 1024 + h * 64;
#pragma unroll
  for (int i = 0; i < 8; ++i) { const int id = i * 512 + tid, key = id >> 3, part = id & 7;
    const u32x4 kv = *(const u32x4*)(kbase + (size_t)key * 3072 + part * 8); const u32x4 vv = *(const u32x4*)(kbase + 1024 + (size_t)key * 3072 + part * 8);
    const int off = (key >> 6) * KROW + (key & 63) * KEYB + part * 16;
    *(LAS u32x4*)(lds + off) = kv; *(LAS u32x4*)(lds + VOFF + off) = vv; }
  const int c = tid >> 3, p = tid & 7;
  const bf16_t* qp = QKV + (size_t)(tok0 + r * 64 + c) * 3072 + h * 64;
  u32x4 q[8];
#pragma unroll
  for (int k = 0; k < 8; ++k) q[k] = *(const u32x4*)(qp + k * 8);
  __syncthreads();
  const int c0 = min(max(c - 8, 0), 48);
  const int kb = p * KROW + c0 * KEYB;
  const float* bp = rpb + (h * 15 + (r0 + p - r + 7)) * 31 + (c0 - c + 15);
  float mx = -1e30f;
#pragma unroll 1
  for (int j = 0; j < 16; ++j) { float s = 0.f;
#pragma unroll
    for (int k = 0; k < 8; ++k) { const u32x4 kv = *(const LAS u32x4*)(lds + kb + j * KEYB + k * 16);
      s = dot2(q[k].x, kv.x, s); s = dot2(q[k].y, kv.y, s); s = dot2(q[k].z, kv.z, s); s = dot2(q[k].w, kv.w, s); }
    mx = fmaxf(mx, s * 0.125f + bp[j]); }
  mx = fmaxf(mx, __shfl_xor(mx, 1)); mx = fmaxf(mx, __shfl_xor(mx, 2)); mx = fmaxf(mx, __shfl_xor(mx, 4));
  float l = 0.f;
  float o[64];
#pragma unroll
  for (int d = 0; d < 64; ++d) o[d] = 0.f;
#pragma unroll 1
  for (int j = 0; j < 16; ++j) { float s = 0.f;
#pragma unroll
    for (int k = 0; k < 8; ++k) { const u32x4 kv = *(const LAS u32x4*)(lds + kb + j * KEYB + k * 16);
      s = dot2(q[k].x, kv.x, s); s = dot2(q[k].y, kv.y, s); s = dot2(q[k].z, kv.z, s); s = dot2(q[k].w, kv.w, s); }
    const float pj = __builtin_amdgcn_exp2f((s * 0.125f + bp[j] - mx) * 1.4426950408889634f); l += pj;
#pragma unroll
    for (int k = 0; k < 8; ++k) { const u32x4 vv = *(const LAS u32x4*)(lds + VOFF + kb + j * KEYB + k * 16);
      o[8 * k + 0] += pj * bflo(vv.x); o[8 * k + 1] += pj * bfhi(vv.x); o[8 * k + 2] += pj * bflo(vv.y); o[8 * k + 3] += pj * bfhi(vv.y);
      o[8 * k + 4] += pj * bflo(vv.z); o[8 * k + 5] += pj * bfhi(vv.z); o[8 * k + 6] += pj * bflo(vv.w); o[8 * k + 7] += pj * bfhi(vv.w); } }
  l += __shfl_xor(l, 1); l += __shfl_xor(l, 2); l += __shfl_xor(l, 4);
  const bool b2 = (p & 4) != 0, b1 = (p & 2) != 0, b0 = (p & 1) != 0;
  float o1[32];
#pragma unroll
  for (int i = 0; i < 32; ++i) { const float snd = b2 ? o[i] : o[i + 32], keep = b2 ? o[i + 32] : o[i]; o1[i] = keep + __shfl_xor(snd, 4); }
  float o2[16];
#pragma unroll
  for (int i = 0; i < 16; ++i) { const float snd = b1 ? o1[i] : o1[i + 16], keep = b1 ? o1[i + 16] : o1[i]; o2[i] = keep + __shfl_xor(snd, 2); }
  float o3[8];
#pragma unroll
  for (int i = 0; i < 8; ++i) { const float snd = b0 ? o2[i] : o2[i + 8], keep = b0 ? o2[i + 8] : o2[i]; o3[i] = keep + __shfl_xor(snd, 1); }
  const float rl = __builtin_amdgcn_rcpf(l);
  u32x4 w; w.x = pk2(o3[0] * rl, o3[1] * rl); w.y = pk2(o3[2] * rl, o3[3] * rl); w.z = pk2(o3[4] * rl, o3[5] * rl); w.w = pk2(o3[6] * rl, o3[7] * rl);
  *(u32x4*)(O + (size_t)(tok0 + r * 64 + c) * 1024 + h * 64 + p * 8) = w;
  __syncthreads();
}
}


namespace na2 {
constexpr int OFF_V = 0, OFF_K = 32768, SHM_K = 64 * 144, OFF_T = OFF_K + 2 * SHM_K, OFF_WS = OFF_T + 15 * 128 * 4, NA_LDS = OFF_WS + 8 * 64 * 4;
__device__ __forceinline__ void na_unit(const bf16_t* __restrict__ QKV, bf16_t* __restrict__ O, const float* __restrict__ rpb, int tok0, int rows, int g4, int h, char* lds) {
  using namespace att;
  int tid_ = threadIdx.x; asm volatile("" : "+v"(tid_));
  const int tid = tid_, wid = __builtin_amdgcn_readfirstlane(tid >> 6), lane = tid & 63, r32 = lane & 31, hi = lane >> 5;
  const int qr = 4 * g4 + (wid >> 1), qh = wid & 1, c = 32 * qh + r32;
  const int krlo = min(max(4 * g4 - 4, 0), rows - 8), krhi = min(max(4 * g4 - 1, 0), rows - 8) + 7, nt = krhi - krlo + 1;
  const int r0w = min(max(qr - 4, 0), rows - 8), c0 = min(max(c - 8, 0), 48);
  float* T = (float*)(lds + OFF_T); float* ws = (float*)(lds + OFF_WS) + wid * 64; float* li_l = ws; float* al_l = ws + 32;
  if (tid < 465) { const int rr = tid / 31, cc = tid - rr * 31; T[rr * 128 + 48 + cc] = rpb[h * 465 + tid]; }
  bf16x8 qf[4];
  { const bf16_t* qp = QKV + (size_t)(tok0 + qr * 64 + c) * 3072 + h * 64 + hi * 8;
#pragma unroll
    for (int d0 = 0; d0 < 4; ++d0) qf[d0] = *reinterpret_cast<const bf16x8*>(qp + d0 * 16); }
  const int skey = tid >> 3, sch = tid & 7;
  const bf16_t* kg = QKV + (size_t)(tok0 + krlo * 64 + skey) * 3072 + 1024 + h * 64 + sch * 8;
  const int kst = skey * 144 + sch * 16, vst = v_st(skey, sch * 8);
  const int vb0 = (int)(uintptr_t)(lds + OFF_V) + v_rd_base(lane);
  bf16x8 sk, sv;
  sk = *(const bf16x8*)kg; sv = *(const bf16x8*)(kg + 1024);
  asm volatile("s_waitcnt vmcnt(0)" ::: "memory");
  *(bf16x8*)(lds + OFF_K + kst) = sk; *(bf16x8*)(lds + OFF_V + vst) = sv;
  __syncthreads();
  float m_reg = -1e30f, l_reg = 0.f; f32x16 o[2] = {};
  const int tb = (48 - c + 15 + 4 * hi);
  for (int t = 0; t < nt; ++t) {
    const int buf = t & 1, kr = krlo + t;
    if (t + 1 < nt) { sk = *(const bf16x8*)(kg + (size_t)(t + 1) * 64 * 3072); sv = *(const bf16x8*)(kg + (size_t)(t + 1) * 64 * 3072 + 1024); }
    if (kr >= r0w && kr <= r0w + 7) {
      const char* Ks = lds + OFF_K + buf * SHM_K;
      f32x16 p0 = {}, p1 = {};
#pragma unroll
      for (int d0 = 0; d0 < 4; ++d0) { const int cb = (d0 * 16 + hi * 8) * 2;
        const bf16x8 b0 = *reinterpret_cast<const bf16x8*>(Ks + r32 * 144 + cb), b1 = *reinterpret_cast<const bf16x8*>(Ks + (32 + r32) * 144 + cb);
        p0 = __builtin_amdgcn_mfma_f32_32x32x16_bf16(b0, qf[d0], p0, 0, 0, 0); p1 = __builtin_amdgcn_mfma_f32_32x32x16_bf16(b1, qf[d0], p1, 0, 0, 0); }
      const float* Tr = T + (kr - qr + 7) * 128 + tb;
#pragma unroll
      for (int r = 0; r < 16; ++r) { const int ko = (r & 3) + 8 * (r >> 2), kc = ko + 4 * hi;
        const bool v0 = (kc >= c0) && (kc <= c0 + 15), v1 = (kc + 32 >= c0) && (kc + 32 <= c0 + 15);
        p0[r] = v0 ? fmaf(p0[r], 0.125f, Tr[ko]) : -1e30f; p1[r] = v1 ? fmaf(p1[r], 0.125f, Tr[ko + 32]) : -1e30f; }
      float mn, al; bf16x8 pa0, pa1, pa2, pa3;
      partialSM<64>(p0, p1, m_reg, mn, al);
      finishSM(p0, p1, al, l_reg, pa0, pa1, pa2, pa3);
      if (__any(al < 1.f)) { if (hi == 0) al_l[r32] = al; asm volatile("s_waitcnt lgkmcnt(0)" ::: "memory");
#pragma unroll
        for (int d = 0; d < 2; ++d)
#pragma unroll
          for (int r = 0; r < 16; ++r) o[d][r] *= al_l[crow(r, hi)]; }
      const int vb = vb0 + buf * 16384;
      pv_one<0>(o[0], vb, pa0, pa1, pa2, pa3); pv_one<1>(o[1], vb, pa0, pa1, pa2, pa3);
    }
    if (t + 1 < nt) { *(bf16x8*)(lds + OFF_K + (buf ^ 1) * SHM_K + kst) = sk; *(bf16x8*)(lds + OFF_V + (buf ^ 1) * 16384 + vst) = sv; }
    __syncthreads();
  }
  if (hi == 0) li_l[r32] = l_reg; asm volatile("s_waitcnt lgkmcnt(0)" ::: "memory");
  bf16_t* Ow = O + (size_t)(tok0 + qr * 64 + 32 * qh) * 1024 + h * 64;
#pragma unroll
  for (int r = 0; r < 16; ++r) { const int orow = crow(r, hi); const float rl = __builtin_amdgcn_rcpf(li_l[orow]);
#pragma unroll
    for (int d0 = 0; d0 < 2; ++d0) Ow[(size_t)orow * 1024 + d0 * 32 + r32] = (bf16_t)(pk2(o[d0][r] * rl, 0.f) & 0xffffu); }
  __syncthreads();
}
}

__device__ __forceinline__ void transpose_item(const float* __restrict__ W, int K, int N, bf16_t* __restrict__ WT, LAS float* scr, int item, int lane, bool ffn_remap = false) {
    const int nblk = N / 32, kb = item / nblk, nb = item % nblk, k0 = 64 * kb, n0 = 32 * nb;
    const int d0 = !ffn_remap ? n0 : (n0 < 4096 ? (n0 >> 7) * 256 + (n0 & 127) : ((n0 - 4096) >> 7) * 256 + 128 + (n0 & 127));
#pragma unroll 8
    for (int i = 0; i < 32; ++i) { const int kk = 2 * i + (lane >> 5); scr[kk * 33 + (lane & 31)] = W[(size_t)(k0 + kk) * N + n0 + (lane & 31)]; }
    asm volatile("s_waitcnt lgkmcnt(0)" ::: "memory");
    const int c = lane & 7;
#pragma unroll
    for (int j = 0; j < 4; ++j) { const int n = (lane >> 3) + 8 * j; const LAS float* s = scr + (8 * c) * 33 + n;
        u32x4 o; o.x = pk2(s[0 * 33], s[1 * 33]); o.y = pk2(s[2 * 33], s[3 * 33]); o.z = pk2(s[4 * 33], s[5 * 33]); o.w = pk2(s[6 * 33], s[7 * 33]);
        *(u32x4*)(WT + (size_t)(d0 + n) * K + k0 + 8 * c) = o; }
    asm volatile("s_waitcnt lgkmcnt(0)" ::: "memory");
}

struct Args { const float* in[28]; float* out; unsigned char* ws; };
typedef const __attribute__((address_space(4))) Args* CArgs;

__device__ __forceinline__ void conv_layer(CArgs a, int L, LAS unsigned char* lds, int gw, int NGW, int lane, int wave, int gtid, int ngt) {
    LAS float* scr = (LAS float*)(lds + wave * 16384);
    unsigned char* wb = a->ws + WS_WB;
    const int kind = L % 3, j = L / 3;
    const float* w_in = a->in[21] + (size_t)L * DM * 2 * FF; const float* w_out = a->in[24] + (size_t)L * FF * DM;
    const float* w_gate = a->in[26] + (size_t)L * DM * DM; const float* w_proj = a->in[25] + (size_t)L * PLE * DM;
    constexpr int I_IN = 16 * 256, I_OUT = 64 * 32, I_GATE = 16 * 32, I_PROJ = 4 * 32, I_O = 16 * 32;
    const float* m1; int m1N; const float* wo;
    if (kind == 0) { m1 = a->in[8] + (size_t)j * DM * 704; m1N = 704; wo = a->in[13] + (size_t)j * DM * DM; }
    else if (kind == 1) { m1 = a->in[14] + (size_t)j * DM * 1536; m1N = 1536; wo = a->in[17] + (size_t)j * DM * DM; }
    else { m1 = a->in[18] + (size_t)j * DM * 3072; m1N = 3072; wo = a->in[20] + (size_t)j * DM * DM; }
    const int I_M1 = 16 * (m1N / 32);
    const int I_UQ = (kind == 0) ? 6 * 48 : 0, I_UKV = (kind == 0) ? 4 * 64 : 0, I_PAD = (kind == 0) ? 128 : 0;
    const int NITEMS = I_IN + I_OUT + I_GATE + I_PROJ + I_O + I_M1 + I_UQ + I_UKV + I_PAD;
    for (int it = gw; it < NITEMS; it += NGW) {
        int r = it;
        if (r < I_IN) { transpose_item(w_in, DM, 2 * FF, (bf16_t*)(wb + WB_IN), scr, r, lane, true); continue; } r -= I_IN;
        if (r < I_OUT) { transpose_item(w_out, FF, DM, (bf16_t*)(wb + WB_OUT), scr, r, lane); continue; } r -= I_OUT;
        if (r < I_GATE) { transpose_item(w_gate, DM, DM, (bf16_t*)(wb + WB_GATE), scr, r, lane); continue; } r -= I_GATE;
        if (r < I_PROJ) { transpose_item(w_proj, PLE, DM, (bf16_t*)(wb + WB_PROJ), scr, r, lane); continue; } r -= I_PROJ;
        if (r < I_O) { transpose_item(wo, DM, DM, (bf16_t*)(wb + WB_O), scr, r, lane); continue; } r -= I_O;
        if (r < I_M1) { transpose_item(m1, DM, m1N, (bf16_t*)(wb + WB_MIX1), scr, r, lane); continue; } r -= I_M1;
        if (r < I_UQ) { transpose_item(a->in[11] + (size_t)j * 384 * 1536, 384, 1536, (bf16_t*)(wb + WB_UQ), scr, r, lane); continue; } r -= I_UQ;
        if (r < I_UKV) { transpose_item(a->in[12] + (size_t)j * 256 * 2048, 256, 2048, (bf16_t*)(wb + WB_UKV), scr, r, lane); continue; } r -= I_UKV;
        { unsigned z = 0u; asm volatile("" : "+v"(z));
          *(u32x4*)(wb + WB_MIX1 + (size_t)704 * 1024 * 2 + (size_t)r * 1024 + lane * 16) = (u32x4){z, z, z, z}; }
    }
    const float* pp = a->in[2] + (size_t)L * HTOK * PLE; const float* ps = a->in[3] + (size_t)L * HTOK * PLE;
    bf16_t* pb = (bf16_t*)(a->ws + WS_PB);
    constexpr int NP8 = NTOK * PLE / 8, HP8 = HTOK * PLE / 8;
    for (int i = gtid; i < NP8; i += ngt) {
        const float* src = (i < HP8) ? pp + (size_t)i * 8 : ps + (size_t)(i - HP8) * 8;
        const f32x4 x0 = *(const f32x4*)src, x1 = *(const f32x4*)(src + 4);
        u32x4 w; w.x = pk2(x0[0], x0[1]); w.y = pk2(x0[2], x0[3]); w.z = pk2(x1[0], x1[1]); w.w = pk2(x1[2], x1[3]);
        *(u32x4*)(pb + (size_t)i * 8) = w;
    }
}

__device__ __forceinline__ void rowpass(CArgs a, int gw, int NGW, int lane, bool init, const bf16_t* __restrict__ src, const float* __restrict__ gadd,
                                        bool has_out, const float* __restrict__ gout, bf16_t* __restrict__ out) {
    constexpr int RP = 4;
    float* X = a->out;
    for (int m0 = gw * RP; m0 < NTOK; m0 += NGW * RP) {
        f32x4 v[RP][4]; u32x2 sv[RP][4];
#pragma unroll
        for (int q = 0; q < RP; ++q) { const int m = m0 + q;
            const float* xin = init ? (m < HTOK ? a->in[0] + (size_t)m * DM : a->in[1] + (size_t)(m - HTOK) * DM) : X + (size_t)m * DM;
#pragma unroll
            for (int j = 0; j < 4; ++j) v[q][j] = *(const f32x4*)(xin + lane * 4 + 256 * j);
            if (src) {
#pragma unroll
                for (int j = 0; j < 4; ++j) sv[q][j] = *(const u32x2*)(src + (size_t)m * DM + lane * 4 + 256 * j);
            } }
        if (src) {
            float ss[RP];
#pragma unroll
            for (int q = 0; q < RP; ++q) { ss[q] = 0.f;
#pragma unroll
                for (int j = 0; j < 4; ++j) { const float s0 = bflo(sv[q][j].x), s1 = bfhi(sv[q][j].x), s2 = bflo(sv[q][j].y), s3 = bfhi(sv[q][j].y); ss[q] += (s0 * s0 + s1 * s1) + (s2 * s2 + s3 * s3); } }
#pragma unroll
            for (int o = 1; o < 64; o <<= 1) {
#pragma unroll
                for (int q = 0; q < RP; ++q) ss[q] += __shfl_xor(ss[q], o); }
#pragma unroll
            for (int j = 0; j < 4; ++j) { const f32x4 g = *(const f32x4*)(gadd + lane * 4 + 256 * j);
#pragma unroll
                for (int q = 0; q < RP; ++q) { const float rs = rsqrtf(ss[q] * (1.f / DM) + EPS);
                    v[q][j][0] += bflo(sv[q][j].x) * rs * g[0]; v[q][j][1] += bfhi(sv[q][j].x) * rs * g[1]; v[q][j][2] += bflo(sv[q][j].y) * rs * g[2]; v[q][j][3] += bfhi(sv[q][j].y) * rs * g[3]; } }
        }
        if (src || init) {
#pragma unroll
            for (int q = 0; q < RP; ++q)
#pragma unroll
                for (int j = 0; j < 4; ++j) *(f32x4*)(X + (size_t)(m0 + q) * DM + lane * 4 + 256 * j) = v[q][j];
        }
        if (has_out) {
            float s2[RP];
#pragma unroll
            for (int q = 0; q < RP; ++q) { s2[q] = 0.f;
#pragma unroll
                for (int j = 0; j < 4; ++j) s2[q] += (v[q][j][0] * v[q][j][0] + v[q][j][1] * v[q][j][1]) + (v[q][j][2] * v[q][j][2] + v[q][j][3] * v[q][j][3]); }
#pragma unroll
            for (int o = 1; o < 64; o <<= 1) {
#pragma unroll
                for (int q = 0; q < RP; ++q) s2[q] += __shfl_xor(s2[q], o); }
#pragma unroll
            for (int j = 0; j < 4; ++j) { f32x4 g = (f32x4){1.f, 1.f, 1.f, 1.f}; if (gout) g = *(const f32x4*)(gout + lane * 4 + 256 * j);
#pragma unroll
                for (int q = 0; q < RP; ++q) { const float r2 = rsqrtf(s2[q] * (1.f / DM) + EPS);
                    u32x2 w; w.x = pk2(v[q][j][0] * r2 * g[0], v[q][j][1] * r2 * g[1]); w.y = pk2(v[q][j][2] * r2 * g[2], v[q][j][3] * r2 * g[3]);
                    *(u32x2*)(out + (size_t)(m0 + q) * DM + lane * 4 + 256 * j) = w; } }
        }
    }
}

__device__ __forceinline__ int tok_pos(int m) { return m < HTOK ? (m & 2047) : (m & 8191); }

__device__ __forceinline__ void mla_c(CArgs a, int jl, int gw, int NGW, int lane) {
    const bf16_t* DOWN = (const bf16_t*)(a->ws + WS_R + R_DOWN); bf16_t* CQ = (bf16_t*)(a->ws + WS_R + R_CQ); bf16_t* CKV = (bf16_t*)(a->ws + WS_R + R_CKV); bf16_t* KR = (bf16_t*)(a->ws + WS_R + R_KROPE);
    const float* qn = a->in[9] + jl * 384; const float* kvn = a->in[10] + jl * 256;
    const float* COS = (const float*)(a->ws + WS_COS); const float* SIN = (const float*)(a->ws + WS_SIN);
    for (int m = gw; m < NTOK; m += NGW) {
        const bf16_t* d = DOWN + (size_t)m * 768;
        unsigned qv[3]; float ss = 0.f;
#pragma unroll
        for (int j = 0; j < 3; ++j) { qv[j] = *(const unsigned*)(d + 2 * lane + 128 * j); const float x0 = bflo(qv[j]), x1 = bfhi(qv[j]); ss += x0 * x0 + x1 * x1; }
        const float rq = rsqrtf(wave_sum(ss) * (1.f / 384.f) + EPS);
#pragma unroll
        for (int j = 0; j < 3; ++j) { const int c = 2 * lane + 128 * j; *(unsigned*)(CQ + (size_t)m * 384 + c) = pk2(bflo(qv[j]) * rq * qn[c], bfhi(qv[j]) * rq * qn[c + 1]); }
        const u32x2 kv = *(const u32x2*)(d + 384 + 4 * lane);
        const float k0 = bflo(kv.x), k1 = bfhi(kv.x), k2 = bflo(kv.y), k3 = bfhi(kv.y);
        const float rk = rsqrtf(wave_sum((k0 * k0 + k1 * k1) + (k2 * k2 + k3 * k3)) * (1.f / 256.f) + EPS);
        const f32x4 g = *(const f32x4*)(kvn + 4 * lane);
        u32x2 w; w.x = pk2(k0 * rk * g[0], k1 * rk * g[1]); w.y = pk2(k2 * rk * g[2], k3 * rk * g[3]);
        *(u32x2*)(CKV + (size_t)m * 256 + 4 * lane) = w;
        const float x = __uint_as_float(((unsigned)d[640 + lane]) << 16);
        const float other = __shfl_xor(x, 32);
        const int pos = tok_pos(m), i = lane & 31;
        const float c = COS[pos * 32 + i], s = SIN[pos * 32 + i];
        const float y = (lane < 32) ? (x * c - other * s) : (x * c + other * s);
        KR[(size_t)m * 64 + lane] = (bf16_t)(pk2(y, 0.f) & 0xffffu);
    }
}

__device__ __forceinline__ void gqa_c(CArgs a, int jl, int gw, int NGW, int lane) {
    bf16_t* QKV = (bf16_t*)(a->ws + WS_R + R_Q);
    const float* qn = a->in[15] + jl * 128; const float* kn = a->in[16] + jl * 128;
    const float* COS = (const float*)(a->ws + WS_COS); const float* SIN = (const float*)(a->ws + WS_SIN);
    const int sub = lane >> 3, part = lane & 7, half = part >> 2, chunk = part & 3;
    for (int m = gw; m < NTOK; m += NGW) {
        const int t = tok_pos(m); const int pos = half == 0 ? (t >> 6) : (t & 63);
        const float* cp = COS + pos * 32 + chunk * 8; const float* sp = SIN + pos * 32 + chunk * 8;
        const f32x4 c0 = *(const f32x4*)cp, c1 = *(const f32x4*)(cp + 4), s0 = *(const f32x4*)sp, s1 = *(const f32x4*)(sp + 4);
#pragma unroll
        for (int pass = 0; pass < 2; ++pass) {
            const int head = pass * 8 + sub; const bool act = head < 10;
            const int hh = act ? head : 0;
            bf16_t* p1 = QKV + (size_t)m * 1536 + hh * 128 + half * 64 + chunk * 8; bf16_t* p2 = p1 + 32;
            const u32x4 a1 = *(const u32x4*)p1, a2 = *(const u32x4*)p2;
            float x1[8] = {bflo(a1.x), bfhi(a1.x), bflo(a1.y), bfhi(a1.y), bflo(a1.z), bfhi(a1.z), bflo(a1.w), bfhi(a1.w)};
            float x2[8] = {bflo(a2.x), bfhi(a2.x), bflo(a2.y), bfhi(a2.y), bflo(a2.z), bfhi(a2.z), bflo(a2.w), bfhi(a2.w)};
            float ss = 0.f;
#pragma unroll
            for (int e = 0; e < 8; ++e) ss += x1[e] * x1[e] + x2[e] * x2[e];
            ss += __shfl_xor(ss, 1); ss += __shfl_xor(ss, 2); ss += __shfl_xor(ss, 4);
            const float rn = rsqrtf(ss * (1.f / 128.f) + EPS);
            const float* gn = (hh < 8 ? qn : kn) + half * 64 + chunk * 8;
            const f32x4 g10 = *(const f32x4*)gn, g11 = *(const f32x4*)(gn + 4), g20 = *(const f32x4*)(gn + 32), g21 = *(const f32x4*)(gn + 36);
            float y1[8], y2[8];
#pragma unroll
            for (int e = 0; e < 8; ++e) { const float c = e < 4 ? c0[e & 3] : c1[e & 3], s = e < 4 ? s0[e & 3] : s1[e & 3];
                const float g1 = e < 4 ? g10[e & 3] : g11[e & 3], g2 = e < 4 ? g20[e & 3] : g21[e & 3];
                const float u1 = x1[e] * rn * g1, u2 = x2[e] * rn * g2; y1[e] = u1 * c - u2 * s; y2[e] = u2 * c + u1 * s; }
            if (act) {
                u32x4 w1 = {pk2(y1[0], y1[1]), pk2(y1[2], y1[3]), pk2(y1[4], y1[5]), pk2(y1[6], y1[7])};
                u32x4 w2 = {pk2(y2[0], y2[1]), pk2(y2[2], y2[3]), pk2(y2[4], y2[5]), pk2(y2[6], y2[7])};
                *(u32x4*)p1 = w1; *(u32x4*)p2 = w2;
            }
        }
    }
}

__device__ __forceinline__ void act_pass(CArgs a, int L, int h, int gtid, int ngt) {
    bf16_t* GU = (bf16_t*)(a->ws + WS_R + R_GU);
    const float* cw = a->in[22] + (size_t)L * 3 * FF; const float* cb = a->in[23] + (size_t)L * FF;
    const int seqm = h == 0 ? 2047 : 8191;
    constexpr int NIT = HTOK * (FF / 8);
    for (int it = gtid; it < NIT; it += ngt) {
        const int t = it >> 9, c = (it & 511) * 8;
        const int pos = t & seqm;
        bf16_t* gp = GU + (size_t)t * 8192 + c;
        const u32x4 z = (u32x4){0u, 0u, 0u, 0u};
        const u32x4 gc = *(const u32x4*)gp;
        const u32x4 gm = pos == 0 ? z : *(const u32x4*)(gp - 8192);
        const u32x4 gn = pos == seqm ? z : *(const u32x4*)(gp + 8192);
        const u32x4 uu = *(const u32x4*)(gp + 4096);
        float w0[8], w1[8], w2[8], bb[8];
        { const f32x4 x0 = *(const f32x4*)(cw + c), x1 = *(const f32x4*)(cw + c + 4), y0 = *(const f32x4*)(cw + FF + c), y1 = *(const f32x4*)(cw + FF + c + 4);
          const f32x4 z0 = *(const f32x4*)(cw + 2 * FF + c), z1 = *(const f32x4*)(cw + 2 * FF + c + 4), b0 = *(const f32x4*)(cb + c), b1 = *(const f32x4*)(cb + c + 4);
#pragma unroll
          for (int e = 0; e < 4; ++e) { w0[e] = x0[e]; w0[e + 4] = x1[e]; w1[e] = y0[e]; w1[e + 4] = y1[e]; w2[e] = z0[e]; w2[e + 4] = z1[e]; bb[e] = b0[e]; bb[e + 4] = b1[e]; } }
        float r[8];
#pragma unroll
        for (int e = 0; e < 4; ++e) {
            const unsigned cm = gm[e], cc = gc[e], cn = gn[e], cu = uu[e];
            const float g0 = w0[2 * e] * bflo(cm) + w1[2 * e] * bflo(cc) + w2[2 * e] * bflo(cn) + bb[2 * e];
            const float g1 = w0[2 * e + 1] * bfhi(cm) + w1[2 * e + 1] * bfhi(cc) + w2[2 * e + 1] * bfhi(cn) + bb[2 * e + 1];
            r[2 * e] = gelu_tanh(g0) * bflo(cu); r[2 * e + 1] = gelu_tanh(g1) * bfhi(cu);
        }
        u32x4 w = {pk2(r[0], r[1]), pk2(r[2], r[3]), pk2(r[4], r[5]), pk2(r[6], r[7])};
        *(u32x4*)(gp + 4096) = w;
    }
}


#define XB_TMO      128
#define XB_XCNT(j)  (256  + 64 * (j))
#define XB_XSUB(j)  (1280 + 64 * (j))
#define XB_XGEN(j)  (2304 + 64 * (j))
#define XB_TOP      3328
#define XB_TOPGEN   3392
#define XCD_BAR_WORDS 3456
#define XB_SPIN_CAP (1u << 20)
__device__ __forceinline__ unsigned xb_ld(unsigned* p)              { return __hip_atomic_load(p, __ATOMIC_RELAXED, __HIP_MEMORY_SCOPE_AGENT); }
__device__ __forceinline__ unsigned xb_add(unsigned* p, unsigned v) { return __hip_atomic_fetch_add(p, v, __ATOMIC_RELAXED, __HIP_MEMORY_SCOPE_AGENT); }
__device__ __forceinline__ unsigned xb_xcc_id() { return (unsigned)__builtin_amdgcn_s_getreg((3 << 11) | 20) & 0xFu; }
#define XB_SPIN(cond, bar) do { unsigned _sp = 0; while (cond) { __builtin_amdgcn_s_sleep(1); \
    if ((++_sp & 255u) == 0u) { if (xb_ld(&(bar)[XB_TMO])) break; if (_sp > XB_SPIN_CAP) { atomicAdd(&(bar)[XB_TMO], 1u); break; } } } } while (0)
struct XcdBarrier { unsigned* bar; unsigned x; volatile LAS unsigned* st; };
__device__ __forceinline__ XcdBarrier xcd_barrier_post(unsigned* bar, volatile LAS unsigned* st) {
    XcdBarrier b; b.bar = bar; b.x = xb_xcc_id(); b.st = st;
    if (threadIdx.x == 0) (void)xb_add(&bar[XB_XCNT(b.x)], 1u);
    return b;
}
__device__ __forceinline__ void xcd_barrier_complete(unsigned* bar, unsigned x, unsigned& nloc, unsigned& nx) {
    const unsigned G = gridDim.x * gridDim.y * gridDim.z;
    unsigned sum, cnt, mine, sp = 0u;
    for (;;) {
        sum = 0u; cnt = 0u; mine = 0u;
#pragma unroll
        for (unsigned j = 0; j < 16; ++j) { const unsigned c = xb_ld(&bar[XB_XCNT(j)]); sum += c; cnt += (c > 0u) ? 1u : 0u; mine = (j == x) ? c : mine; }
        if (sum == G) break;
        __builtin_amdgcn_s_sleep(1);
        if ((++sp & 255u) == 0u) { if (xb_ld(&bar[XB_TMO])) break; if (sp > XB_SPIN_CAP) { atomicAdd(&bar[XB_TMO], 1u); break; } }
    }
    nloc = mine > 0u ? mine : 1u; nx = cnt > 0u ? cnt : 1u;
}
__device__ __forceinline__ void xcd_barrier(const XcdBarrier& b) {
    asm volatile("s_waitcnt vmcnt(0)" ::: "memory");
    __syncthreads();
    if (threadIdx.x == 0) {
        unsigned* bar = b.bar;
        __builtin_amdgcn_s_waitcnt(0);
        unsigned nloc = b.st[0], nx = b.st[1];
        if (nloc == 0u) { xcd_barrier_complete(bar, b.x, nloc, nx); b.st[0] = nloc; b.st[1] = nx; }
        const unsigned old = xb_add(&bar[XB_XSUB(b.x)], 1u);
        const unsigned gen = old / nloc;
        if (old + 1u == (gen + 1u) * nloc) {
            __builtin_amdgcn_fence(__ATOMIC_RELEASE, "agent");
            asm volatile("s_waitcnt vmcnt(0)" ::: "memory");
            const unsigned og = xb_add(&bar[XB_TOP], 1u);
            const unsigned tg = og / nx;
            if (og + 1u == (tg + 1u) * nx) xb_add(&bar[XB_TOPGEN], 1u);
            else XB_SPIN(xb_ld(&bar[XB_TOPGEN]) == tg, bar);
            __builtin_amdgcn_fence(__ATOMIC_ACQUIRE, "agent");
            xb_add(&bar[XB_XGEN(b.x)], 1u);
            asm volatile("s_waitcnt vmcnt(0)" ::: "memory");
        } else {
            XB_SPIN(xb_ld(&bar[XB_XGEN(b.x)]) == gen, bar);
            __builtin_amdgcn_fence(__ATOMIC_ACQUIRE, "agent");
            asm volatile("s_waitcnt vmcnt(0)" ::: "memory");
        }
    }
    __syncthreads();
}

enum { OP_NONE = 0, OP_GEMM, OP_MLAC, OP_GQAC, OP_ATT_MLA, OP_ATT_GQA, OP_ATT_NA, OP_ROW, OP_ACT };

__global__ void __launch_bounds__(512) fwd_mega(Args a_kernarg) {
    extern __shared__ __attribute__((aligned(16))) unsigned char lds_raw[];
    cg::grid_group grid = cg::this_grid();
    LAS unsigned char* lds = (LAS unsigned char*)lds_raw;
    const int G = gridDim.x, bx = blockIdx.x;
    const int vcu = (G % 8 == 0) ? (bx % 8) * (G / 8) + bx / 8 : bx;
    const int NGW = G * 8, ngt = G * 512;
#define LAUNDER_TID() CArgs a = (CArgs)__builtin_amdgcn_kernarg_segment_ptr(); asm volatile("" : "+s"(a)); int tl_ = threadIdx.x; asm volatile("" : "+v"(tl_)); const int tid = tl_, lane = tid & 63, wave = __builtin_amdgcn_readfirstlane(tid >> 6); const int gw = vcu * 8 + wave, gtid = bx * 512 + tid
    unsigned char* ws = a_kernarg.ws;
    if (threadIdx.x < 2) ((volatile LAS unsigned*)(lds + LDS_MISC))[threadIdx.x] = 0u;
    __syncthreads();
    const XcdBarrier xbar = xcd_barrier_post((unsigned*)ws, (volatile LAS unsigned*)(lds + LDS_MISC));
    float* COS = (float*)(ws + WS_COS); float* SIN = (float*)(ws + WS_SIN);
    bf16_t* HN = (bf16_t*)(ws + WS_HN); bf16_t* PB = (bf16_t*)(ws + WS_PB);
    unsigned char* R = ws + WS_R; unsigned char* WB = ws + WS_WB;

    {
    LAUNDER_TID();
    for (int i = gtid; i < 8192 * 32; i += ngt) {
        const int pos = i >> 5, f = i & 31;
        double inv = 1.0; for (int k = 0; k < f; ++k) inv *= 0.74989420933245582730;
        const double rev = (double)pos * inv * 0.15915494309189535;
        const double fr = rev - __builtin_rint(rev);
        const float ff = (float)fr;
        COS[i] = __builtin_amdgcn_cosf(ff); SIN[i] = __builtin_amdgcn_sinf(ff);
    }
#if EN_INIT
    conv_layer(a, 0, lds, gw, NGW, lane, wave, gtid, ngt);
#endif
    rowpass(a, gw, NGW, lane, true, nullptr, nullptr, true, a->in[4], HN);
    }
    if (G > (1 << 24)) grid.sync();
    xcd_barrier(xbar);

    for (int L = 0; L < 4; ++L) {
        const int kind = L % 3, jl = L / 3;
        for (int s = 0; s < 17; ++s) {
            asm volatile("s_nop 0");
            LAUNDER_TID();
            int op = OP_NONE; bool sync = true;
            pg8::Gemm gj{nullptr, nullptr, NTOK, 0, 0, 0, 0}; pg8::Epi ep{nullptr, 0, nullptr, 0, nullptr, nullptr, (LAS float*)(lds + 131072)};
            const bf16_t* rsrc = nullptr; const float* rgadd = nullptr; const float* rgout = nullptr; bool rhas = true; int hh = 0;
            switch (s) {
            case 0: op = OP_GEMM; gj.A = HN; gj.lda = DM; gj.Bt = (const bf16_t*)(WB + WB_MIX1); gj.K = DM;
                    if (kind == 0) { gj.N = 768; ep.O = (bf16_t*)(R + R_DOWN); } else if (kind == 1) { gj.N = 1536; ep.O = (bf16_t*)(R + R_Q); } else { gj.N = 3072; ep.O = (bf16_t*)(R + R_Q); }
                    ep.ldc = gj.N; break;
            case 1: if (kind == 0) op = OP_MLAC; else if (kind == 1) op = OP_GQAC; else sync = false; break;
            case 2: sync = false; if (kind == 0) { op = OP_GEMM; gj.A = (const bf16_t*)(R + R_CQ); gj.lda = 384; gj.Bt = (const bf16_t*)(WB + WB_UQ); gj.N = 1536; gj.K = 384; ep.O = (bf16_t*)(R + R_Q); ep.ldc = 1536; } break;
            case 3: if (kind == 0) { op = OP_GEMM; gj.A = (const bf16_t*)(R + R_CKV); gj.lda = 256; gj.Bt = (const bf16_t*)(WB + WB_UKV); gj.N = 2048; gj.K = 256; ep.O = (bf16_t*)(R + R_KV); ep.ldc = 2048; } else sync = false; break;
            case 4: op = kind == 0 ? OP_ATT_MLA : (kind == 1 ? OP_ATT_GQA : OP_ATT_NA); break;
            case 5: op = OP_GEMM; gj.A = (const bf16_t*)(R + R_O); gj.lda = DM; gj.Bt = (const bf16_t*)(WB + WB_O); gj.N = DM; gj.K = DM; ep.O = HN; ep.ldc = DM; break;
            case 6: op = OP_ROW; rsrc = HN; rgadd = a->in[5] + L * DM; rgout = a->in[6] + L * DM; break;
            case 7: op = OP_GEMM; gj.A = HN; gj.lda = DM; gj.Bt = (const bf16_t*)(WB + WB_IN); gj.M = 130 * 256; gj.N = 2 * FF; gj.K = DM; gj.ffn = 1;
                    ep.O = (bf16_t*)(R + R_GU); ep.ldc = FF; ep.mode = 2; ep.cw = a->in[22] + (size_t)L * 3 * FF; ep.cb = a->in[23] + (size_t)L * FF; break;
            case 9: op = OP_GEMM; gj.A = (const bf16_t*)(R + R_GU); gj.lda = FF; gj.Bt = (const bf16_t*)(WB + WB_OUT); gj.N = DM; gj.K = FF; ep.O = HN; ep.ldc = DM; break;
            case 8: op = OP_GEMM; gj.A = PB; gj.lda = PLE; gj.Bt = (const bf16_t*)(WB + WB_PROJ); gj.N = DM; gj.K = PLE; ep.O = (bf16_t*)(ws + WS_E); ep.ldc = DM; break;
            case 10: case 11: case 12: case 14: sync = false; break;
            case 13: op = OP_ROW; rsrc = HN; rgadd = a->in[7] + L * DM; rgout = nullptr; break;
            case 15: op = OP_GEMM; gj.A = HN; gj.lda = DM; gj.Bt = (const bf16_t*)(WB + WB_GATE); gj.N = DM; gj.K = DM; ep.O = (bf16_t*)(R + R_GE); ep.ldc = DM; ep.E = (const bf16_t*)(ws + WS_E); ep.mode = 1; break;
            default: op = OP_ROW; rsrc = (const bf16_t*)(R + R_GE); rgadd = a->in[27] + L * DM; if (L < 3) rgout = a->in[4] + (L + 1) * DM; else { rhas = false; sync = false; } break;
            }
            if (op == OP_GEMM) {
                pg8::StaticOrder S;
                if (s == 8) {
                    const int nfull = (130 * 32) % G;
                    if (nfull > 0 && nfull < G) { if (bx >= nfull) S.init(gj.M, gj.N, G - nfull, bx - nfull); else S.init(0, gj.N, G, bx); }
                    else S.init(gj.M, gj.N, G, bx);
                } else S.init(gj.M, gj.N, G, bx);
#if EN_GEMM
                pg8::gemm_phase(lds, gj, S, ep, tid);
#endif
            } else if (op == OP_ROW) {
#if EN_ROW
                rowpass(a, gw, NGW, lane, false, rsrc, rgadd, rhas, rgout, HN);
                if (s == 16 && L < 3) conv_layer(a, L + 1, lds, gw, NGW, lane, wave, gtid, ngt);
#endif
            } else if (op == OP_ACT) {
#if EN_ACT
                act_pass(a, L, hh, gtid, ngt);
#endif
            } else if (op == OP_MLAC) {
#if EN_MLAC
                mla_c(a, jl, gw, NGW, lane);
#endif
            } else if (op == OP_GQAC) {
#if EN_GQAC
                gqa_c(a, jl, gw, NGW, lane);
#endif
            } else if (op == OP_ATT_MLA) {
                const bf16_t* Q = (const bf16_t*)(R + R_Q); const bf16_t* KV = (const bf16_t*)(R + R_KV); const bf16_t* KR = (const bf16_t*)(R + R_KROPE); bf16_t* O = (bf16_t*)(R + R_O);
                unsigned* ctr = (unsigned*)ws + XCD_BAR_WORDS + 64 * (L + 1);
                volatile LAS unsigned* uw = (volatile LAS unsigned*)(lds + LDS_MISC + 16);
                int uu = vcu; bool dyn = false;
                for (;;) {
                    if (!dyn && uu >= 512) dyn = true;
                    if (dyn) { if (tid == 0) uw[0] = 512u + atomicAdd(ctr, 1u); __syncthreads(); uu = __builtin_amdgcn_readfirstlane((int)uw[0]); __syncthreads(); if (uu >= 1024) break; }
                    int rowbase, seq, qb, h;
                    if (uu < 512) { qb = uu & 31; h = (uu >> 5) & 7; rowbase = HTOK + (uu >> 8) * 8192; seq = 8192; }
                    else { const int u = uu - 512; qb = u & 7; h = (u >> 3) & 7; rowbase = (u >> 6) * 2048; seq = 2048; }
                    const bf16_t* Kh = KV + (size_t)rowbase * 2048 + h * 256;
#if EN_AMLA
                    att::attn_unit<192, 2048>(Q + (size_t)(rowbase + qb * 256) * 1536 + h * 192, Kh, Kh + 128, KR + (size_t)rowbase * 64,
                                              O + (size_t)(rowbase + qb * 256) * 1024 + h * 128, seq, qb * 256, COS, SIN, (char*)lds_raw);
#endif
                    if (!dyn) uu += G;
                }
            } else if (op == OP_ATT_GQA) {
                const bf16_t* QKV = (const bf16_t*)(R + R_Q); bf16_t* O = (bf16_t*)(R + R_O);
                unsigned* ctr = (unsigned*)ws + XCD_BAR_WORDS + 64 * (L + 1);
                volatile LAS unsigned* uw = (volatile LAS unsigned*)(lds + LDS_MISC + 16);
                int uu = vcu; bool dyn = false;
                for (;;) {
                    if (!dyn && uu >= 512) dyn = true;
                    if (dyn) { if (tid == 0) uw[0] = 512u + atomicAdd(ctr, 1u); __syncthreads(); uu = __builtin_amdgcn_readfirstlane((int)uw[0]); __syncthreads(); if (uu >= 1024) break; }
                    int rowbase, seq, qb, h;
                    if (uu < 512) { qb = uu & 31; h = (uu >> 5) & 7; rowbase = HTOK + (uu >> 8) * 8192; seq = 8192; }
                    else { const int u = uu - 512; qb = u & 7; h = (u >> 3) & 7; rowbase = (u >> 6) * 2048; seq = 2048; }
                    const bf16_t* Kh = QKV + (size_t)rowbase * 1536 + 1024 + (h >> 2) * 128;
#if EN_AGQA
                    att::attn_unit<128, 1536>(QKV + (size_t)(rowbase + qb * 256) * 1536 + h * 128, Kh, Kh + 256, nullptr,
                                              O + (size_t)(rowbase + qb * 256) * 1024 + h * 128, seq, qb * 256, COS, SIN, (char*)lds_raw);
#endif
                    if (!dyn) uu += G;
                }
            } else if (op == OP_ATT_NA) {
                const bf16_t* QKV = (const bf16_t*)(R + R_Q); bf16_t* O = (bf16_t*)(R + R_O);
                const float* rpb = a->in[19] + (size_t)jl * 16 * 15 * 31;
                for (int uu = vcu; uu < 2048; uu += G) {
                    int tok0, rows, g4, h;
                    if (uu < 1024) { h = uu & 15; g4 = (uu >> 4) & 7; tok0 = (uu >> 7) * 2048; rows = 32; }
                    else { const int u = uu - 1024; h = u & 15; g4 = (u >> 4) & 31; tok0 = HTOK + (u >> 9) * 8192; rows = 128; }
#if EN_NA
                    na2::na_unit(QKV, O, rpb, tok0, rows, g4, h, (char*)lds_raw);
#endif
                }
            }
            (void)sync;
            {
                int s2 = s; asm volatile("" : "+s"(s2));
                const bool need = (s2 == 1) ? (kind != 2) : (s2 == 3) ? (kind == 0) : (s2 == 16) ? (L < 3) : !(s2 == 2 || s2 == 7 || (s2 >= 10 && s2 <= 12) || s2 == 14);
                if (need) xcd_barrier(xbar);
            }
        }
    }
}

extern "C" void kernel_launch(void* const* d_in, const int* in_sizes, int n_in, void* d_out, int out_size, void* d_ws, size_t ws_size, hipStream_t stream) {
    static int grid = 0;
    if (grid == 0) {
        if (n_in != 28 || out_size != NTOK * DM || ws_size < WS_END) { fprintf(stderr, "kernel_launch: unexpected shapes (n_in %d out %d ws %zu need %zu)\n", n_in, out_size, ws_size, (size_t)WS_END); grid = -1; return; }
        int dev = 0, cus = 0, per = 0;
        (void)hipGetDevice(&dev); (void)hipDeviceGetAttribute(&cus, hipDeviceAttributeMultiprocessorCount, dev);
        (void)hipFuncSetAttribute((const void*)fwd_mega, hipFuncAttributeMaxDynamicSharedMemorySize, LDS_BYTES);
        (void)hipOccupancyMaxActiveBlocksPerMultiprocessor(&per, (const void*)fwd_mega, 512, LDS_BYTES);
        if (per < 1) per = 1;
        grid = cus * per;
        fprintf(stderr, "kernel_launch: cus %d per_cu %d grid %d ws %zu\n", cus, per, grid, ws_size);
    }
    if (grid < 0) return;
    (void)hipMemsetAsync(d_ws, 0, 16384, stream);
    Args a{};
    for (int i = 0; i < 28; ++i) a.in[i] = (const float*)d_in[i];
    a.out = (float*)d_out; a.ws = (unsigned char*)d_ws;
    void* args[] = {&a};
    hipError_t e = hipLaunchCooperativeKernel((const void*)fwd_mega, dim3(grid), dim3(512), args, LDS_BYTES, stream);
    if (e != hipSuccess) fprintf(stderr, "kernel_launch: cooperative launch failed: %s (grid %d)\n", hipGetErrorString(e), grid);
}
```

```cpp
#include <hip/hip_runtime.h>
#include <hip/hip_cooperative_groups.h>
#include <cstdio>
#include <cstdint>
#include <cmath>
namespace cg = cooperative_groups;
#ifndef EN_ALL
#define EN_ALL 1
#endif
#ifndef EN_GEMM
#define EN_GEMM EN_ALL
#endif
#ifndef EN_ROW
#define EN_ROW EN_ALL
#endif
#ifndef EN_ACT
#define EN_ACT EN_ALL
#endif
#ifndef EN_MLAC
#define EN_MLAC EN_ALL
#endif
#ifndef EN_GQAC
#define EN_GQAC EN_ALL
#endif
#ifndef EN_AMLA
#define EN_AMLA EN_ALL
#endif
#ifndef EN_AGQA
#define EN_AGQA EN_ALL
#endif
#ifndef EN_NA
#define EN_NA EN_ALL
#endif
#ifndef EN_INIT
#define EN_INIT EN_ALL
#endif

#define LAS __attribute__((address_space(3)))
typedef unsigned short bf16_t;
typedef short bf16x8 __attribute__((ext_vector_type(8)));
typedef short s16x4 __attribute__((ext_vector_type(4)));
typedef float f32x4 __attribute__((ext_vector_type(4)));
typedef float f32x16 __attribute__((ext_vector_type(16)));
typedef float f32x2_t __attribute__((ext_vector_type(2)));
typedef __bf16 bf16x2_t __attribute__((ext_vector_type(2)));
typedef unsigned u32x4 __attribute__((ext_vector_type(4)));
typedef unsigned u32x2 __attribute__((ext_vector_type(2)));

constexpr int NTOK = 32768, HTOK = 16384, DM = 1024, FF = 4096, PLE = 256;
constexpr float EPS = 1e-6f;
constexpr size_t MiB = 1u << 20;
constexpr size_t WS_COS = 1 * MiB, WS_SIN = 2 * MiB, WS_WB = 4 * MiB, WS_PB = 40 * MiB, WS_HN = 56 * MiB, WS_R = 120 * MiB, WS_E = 412 * MiB, WS_END = 476 * MiB;
constexpr size_t WB_IN = 0, WB_OUT = 16 * MiB, WB_GATE = 24 * MiB, WB_PROJ = 26 * MiB, WB_MIX1 = 27 * MiB, WB_UQ = 29 * MiB, WB_UKV = 31 * MiB, WB_O = 34 * MiB;
constexpr size_t R_Q = 0, R_KV = 96 * MiB, R_DOWN = 96 * MiB, R_O = 224 * MiB, R_CQ = 224 * MiB, R_CKV = 248 * MiB, R_KROPE = 288 * MiB, R_GU = 0, R_E = 0, R_GE = 64 * MiB;
constexpr int LDS_BYTES = 148480, LDS_MISC = 148000;

__device__ __forceinline__ unsigned pk2(float lo, float hi) { f32x2_t v = {lo, hi}; bf16x2_t b = __builtin_convertvector(v, bf16x2_t); return __builtin_bit_cast(unsigned, b); }
__device__ __forceinline__ float bflo(unsigned u) { return __uint_as_float(u << 16); }
__device__ __forceinline__ float bfhi(unsigned u) { return __uint_as_float(u & 0xffff0000u); }
__device__ __forceinline__ float wave_sum(float v) {
#pragma unroll
    for (int o = 1; o < 64; o <<= 1) v += __shfl_xor(v, o);
    return v;
}
__device__ __forceinline__ float fast_sigmoid(float z) { return __builtin_amdgcn_rcpf(1.0f + __builtin_amdgcn_exp2f(-1.4426950408889634f * z)); }
__device__ __forceinline__ float gelu_tanh(float g) { const float z = 1.5957691216057308f * (g + 0.044715f * g * g * g); return g * fast_sigmoid(z); }

namespace pg8 {
constexpr int BM = 256, BK = 64, HALF = 128, HTB = HALF * BK * 2, STAGE_BYTES = 8 * HTB, NXCD = 8, WGM = 8;
__device__ __forceinline__ int lds_byte(int r, int c) { const int st = (r >> 4) * 2 + (c >> 5), rr = r & 15, cc = c & 31, ob = rr * 64 + cc * 2; return st * 1024 + (ob ^ (((ob >> 9) & 1) << 5)); }
__device__ __forceinline__ void stage_rc(int b, int& R, int& C) { const int st = b / 1024, sb = b % 1024, swz = sb ^ (((sb >> 9) & 1) << 5); R = (st >> 1) * 16 + swz / 64; C = (st & 1) * 32 + (swz % 64) / 2; }
__device__ __forceinline__ int perm32(int rho) { const int n = rho >> 4, i = rho & 15; return 8 * (i >> 2) + 4 * n + (i & 3); }
struct Unit { int pm, pn; };
struct Gemm { const bf16_t* A; const bf16_t* Bt; int M, N, K, lda, ffn; };
__device__ __forceinline__ void ffn_tile(int pm, int& tok0) { tok0 = 254 * pm - 1; }
__device__ __forceinline__ long a_row0(const Gemm& g, int pm) { if (!g.ffn) return (long)pm * BM; int tok0; ffn_tile(pm, tok0); return (long)tok0; }
struct StaticOrder {
    int nM, nN, nwg, G, c;
    __device__ __forceinline__ void init(int M, int N, int G_, int c_) { nM = M / BM; nN = N / BM; nwg = nM * nN; G = G_; c = c_; }
    __device__ __forceinline__ bool next(int i, Unit& u) const {
        const long L = (long)i * G + c; if (L >= nwg) return false;
        int wgid = (int)L; { const int q = nwg / NXCD, r = nwg % NXCD, xcd = wgid % NXCD, off = wgid / NXCD; wgid = (xcd < r ? xcd * (q + 1) : r * (q + 1) + (xcd - r) * q) + off; }
        const int nig = WGM * nN, gid = wgid / nig, fm = gid * WGM, gsz = (nM - fm) < WGM ? (nM - fm) : WGM;
        u.pm = fm + ((wgid % nig) % gsz); u.pn = (wgid % nig) / gsz; return true;
    }
};
struct Epi {
    bf16_t* O; int ldc; const bf16_t* E; int mode; const float* cw; const float* cb; LAS float* xl;
    __device__ __forceinline__ void ffn(const f32x4 (&acc)[2][2][4][2], const Unit& u, int wr, int wc, int fr, int fq, int lane) const {
        int tok0; ffn_tile(u.pm, tok0);
        const int colw = wc * 32 + 8 * fq;
        const int gcol = u.pn * 128 + colw;
        f32x4 w0[2], w1[2], w2[2], bb[2];
#pragma unroll
        for (int n = 0; n < 2; ++n) { w0[n] = *(const f32x4*)(cw + gcol + 4 * n); w1[n] = *(const f32x4*)(cw + 4096 + gcol + 4 * n); w2[n] = *(const f32x4*)(cw + 8192 + gcol + 4 * n); bb[n] = *(const f32x4*)(cb + gcol + 4 * n); }
#pragma unroll
        for (int ai = 0; ai < 2; ++ai) { const int c = 2 * ai + wr;
            if (fr == 0) { *(LAS f32x4*)(xl + (c * 2 + 0) * 128 + colw) = acc[ai][0][0][0]; *(LAS f32x4*)(xl + (c * 2 + 0) * 128 + colw + 4) = acc[ai][0][0][1]; }
            if (fr == 15) { *(LAS f32x4*)(xl + (c * 2 + 1) * 128 + colw) = acc[ai][0][3][0]; *(LAS f32x4*)(xl + (c * 2 + 1) * 128 + colw + 4) = acc[ai][0][3][1]; } }
        asm volatile("s_waitcnt lgkmcnt(0)" ::: "memory"); __builtin_amdgcn_s_barrier(); asm volatile("" ::: "memory");
#pragma unroll
        for (int ai = 0; ai < 2; ++ai) { const int c = 2 * ai + wr;
            f32x4 xup[2], xdn[2];
#pragma unroll
            for (int n = 0; n < 2; ++n) { xup[n] = c > 0 ? *(const LAS f32x4*)(xl + ((c - 1) * 2 + 1) * 128 + colw + 4 * n) : (f32x4){0.f, 0.f, 0.f, 0.f};
                                          xdn[n] = c < 3 ? *(const LAS f32x4*)(xl + ((c + 1) * 2 + 0) * 128 + colw + 4 * n) : (f32x4){0.f, 0.f, 0.f, 0.f}; }
#pragma unroll
            for (int m = 0; m < 4; ++m) {
                const int lr = 128 * ai + 64 * wr + 16 * m + fr, tok = tok0 + lr, Lm = tok < HTOK ? 2047 : 8191, pos = tok & Lm;
                u32x4 w;
#pragma unroll
                for (int n = 0; n < 2; ++n) {
                    f32x4 up, dn; const f32x4 cur = acc[ai][0][m][n];
#pragma unroll
                    for (int e = 0; e < 4; ++e) {
                        const float su = (fr == 15 && m > 0) ? acc[ai][0][m > 0 ? m - 1 : 0][n][e] : cur[e];
                        const float sd = (fr == 0 && m < 3) ? acc[ai][0][m < 3 ? m + 1 : 3][n][e] : cur[e];
                        { const int a = __float_as_int(su), b = __float_as_int(sd);
                          up[e] = __int_as_float(__builtin_amdgcn_update_dpp(a, a, 0x121, 0xf, 0xf, false));
                          dn[e] = __int_as_float(__builtin_amdgcn_update_dpp(b, b, 0x12F, 0xf, 0xf, false)); }
                    }
                    if (m == 0 && fr == 0) up = xup[n];
                    if (m == 3 && fr == 15) dn = xdn[n];
                    if (pos == 0) up = (f32x4){0.f, 0.f, 0.f, 0.f};
                    if (pos == Lm) dn = (f32x4){0.f, 0.f, 0.f, 0.f};
                    const f32x4 g = w0[n] * up + w1[n] * cur + w2[n] * dn + bb[n]; const f32x4 uu = acc[ai][1][m][n];
                    const float r0 = gelu_tanh(g[0]) * uu[0], r1 = gelu_tanh(g[1]) * uu[1], r2 = gelu_tanh(g[2]) * uu[2], r3 = gelu_tanh(g[3]) * uu[3];
                    if (n == 0) { w.x = pk2(r0, r1); w.y = pk2(r2, r3); } else { w.z = pk2(r0, r1); w.w = pk2(r2, r3); }
                }
                { const bool ok = lr >= 1 && lr <= 254 && tok < NTOK; *(u32x4*)(O + (size_t)(ok ? tok : NTOK) * 4096 + gcol) = w; }
            }
        }
    }
    __device__ __forceinline__ void operator()(const f32x4 (&acc)[2][2][4][2], const Unit& u, int wr, int wc, int fr, int fq) const {
        const int row0 = u.pm * BM + wr * 64 + fr; const int col0 = u.pn * BM + wc * 32 + 8 * fq;
#pragma unroll
        for (int ai = 0; ai < 2; ++ai)
#pragma unroll
            for (int m = 0; m < 4; ++m) {
                const size_t ro = (size_t)(row0 + ai * HALF + m * 16) * ldc + col0;
#pragma unroll
                for (int bj = 0; bj < 2; ++bj) {
                    f32x4 v0 = acc[ai][bj][m][0], v1 = acc[ai][bj][m][1];
                    if (mode == 1) {
                        const u32x4 e = *(const u32x4*)(E + ro + bj * HALF);
                        v0[0] = fast_sigmoid(v0[0]) * bflo(e.x); v0[1] = fast_sigmoid(v0[1]) * bfhi(e.x); v0[2] = fast_sigmoid(v0[2]) * bflo(e.y); v0[3] = fast_sigmoid(v0[3]) * bfhi(e.y);
                        v1[0] = fast_sigmoid(v1[0]) * bflo(e.z); v1[1] = fast_sigmoid(v1[1]) * bfhi(e.z); v1[2] = fast_sigmoid(v1[2]) * bflo(e.w); v1[3] = fast_sigmoid(v1[3]) * bfhi(e.w);
                    }
                    u32x4 w; w.x = pk2(v0[0], v0[1]); w.y = pk2(v0[2], v0[3]); w.z = pk2(v1[0], v1[1]); w.w = pk2(v1[2], v1[3]);
                    *(u32x4*)(O + ro + bj * HALF) = w;
                }
            }
    }
};

__device__ __forceinline__ void gemm_phase(LAS unsigned char* lds, const Gemm g, const StaticOrder& S, const Epi& E, const int tid) {
    const int wid = __builtin_amdgcn_readfirstlane(tid >> 6), lane = tid & 63, wr = wid >> 2, wc = wid & 3, fr = lane & 15, fq = lane >> 4;
    const int K = g.K, nt = K / BK, lda = g.lda;
    unsigned voffA[2], voffB[2];
#pragma unroll
    for (int i = 0; i < 2; ++i) { int R, C; stage_rc(tid * 16 + i * 8192, R, C); const int Rb = (R & ~31) + perm32(R & 31);
        voffA[i] = (unsigned)(R * lda + C) * 2u; voffB[i] = (unsigned)(Rb * K + C) * 2u; }
    const size_t kstep = (size_t)(BK * 2);
    const size_t hstepA = (size_t)HALF * lda * 2, hstepB = (size_t)HALF * K * 2;
    const size_t tstepB = 2 * hstepB;
    const unsigned ldsw = (unsigned)wid * 1024u;
    const int aoff = lds_byte(wr * 64 + fr, fq * 8), boff = lds_byte(wc * 32 + fr, fq * 8);
#define PG8_SA(b, h) (((b) * 2 + (h)) * HTB)
#define PG8_SB(b, h) ((4 + (b) * 2 + (h)) * HTB)
#define PG8_STAGE(bufoff, gbase, voff) do { _Pragma("unroll") for (int _i = 0; _i < 2; ++_i) \
        __builtin_amdgcn_global_load_lds((const unsigned*)((const char*)(gbase) + (voff)[_i]), (LAS unsigned*)(lds + (bufoff) + ldsw + _i * 8192), 16, 0, 0); } while (0)
#define PG8_LDA(dst, b, h) do { _Pragma("unroll") for (int m = 0; m < 4; ++m) _Pragma("unroll") for (int k = 0; k < 2; ++k) dst[m][k] = *(const LAS bf16x8*)(lds + PG8_SA(b, h) + aoff + m * 2048 + k * 1024); } while (0)
#define PG8_LDB(dst, b, h) do { _Pragma("unroll") for (int n = 0; n < 2; ++n) _Pragma("unroll") for (int k = 0; k < 2; ++k) dst[n][k] = *(const LAS bf16x8*)(lds + PG8_SB(b, h) + boff + n * 2048 + k * 1024); } while (0)
#define PG8_MMA(ai, bj, At, Bt) do { __builtin_amdgcn_s_setprio(1); _Pragma("unroll") for (int m = 0; m < 4; ++m) _Pragma("unroll") for (int n = 0; n < 2; ++n) _Pragma("unroll") for (int k = 0; k < 2; ++k) \
        acc[ai][bj][m][n] = __builtin_amdgcn_mfma_f32_16x16x32_bf16(Bt[n][k], At[m][k], acc[ai][bj][m][n], 0, 0, 0); __builtin_amdgcn_s_setprio(0); } while (0)
#define PG8_WAIT_V(n) asm volatile("s_waitcnt vmcnt(" #n ")" ::: "memory")
#define PG8_WAIT_L(n) asm volatile("s_waitcnt lgkmcnt(" #n ")" ::: "memory")
#define PG8_BAR __builtin_amdgcn_s_barrier()
#define PG8_SCHED __builtin_amdgcn_sched_barrier(0)
    Unit cur, nxt; int ui = 0;
    if (!S.next(0, cur)) return;
    f32x4 acc[2][2][4][2];
#pragma unroll
    for (int a = 0; a < 2; ++a)
#pragma unroll
        for (int b = 0; b < 2; ++b)
#pragma unroll
            for (int m = 0; m < 4; ++m)
#pragma unroll
                for (int n = 0; n < 2; ++n) acc[a][b][m][n] = (f32x4){0.f, 0.f, 0.f, 0.f};
    bf16x8 At[4][2], B0[2][2], B1[2][2];
    const long rowbA = (long)lda * 2;
    const char* cA = (const char*)g.A + a_row0(g, cur.pm) * rowbA; const char* cB = (const char*)g.Bt + (size_t)cur.pn * tstepB;
    PG8_STAGE(PG8_SB(0, 0), cB, voffB); PG8_STAGE(PG8_SB(0, 1), cB + hstepB, voffB); PG8_STAGE(PG8_SA(0, 0), cA, voffA); PG8_STAGE(PG8_SA(0, 1), cA + hstepA, voffA);
    if (wr == 1) PG8_BAR;
    PG8_WAIT_V(2); PG8_BAR;
    PG8_STAGE(PG8_SB(1, 0), cB + kstep, voffB); PG8_STAGE(PG8_SA(1, 0), cA + kstep, voffA); PG8_STAGE(PG8_SB(1, 1), cB + hstepB + kstep, voffB);
    PG8_WAIT_V(6); PG8_BAR;
    for (;;) {
        const bool has_next = S.next(ui + 1, nxt);
        const char* nA = has_next ? (const char*)g.A + a_row0(g, nxt.pm) * rowbA : cA; const char* nB = has_next ? (const char*)g.Bt + (size_t)nxt.pn * tstepB : cB;
        for (int t = 0; t < nt; t += 2) {
            const bool last = (t == nt - 2);
            const char* a1 = cA + (size_t)(t + 1) * kstep;
            const char* a2 = last ? nA : cA + (size_t)(t + 2) * kstep; const char* b2 = last ? nB : cB + (size_t)(t + 2) * kstep;
            const char* a3 = a2 + kstep; const char* b3 = b2 + kstep;
            PG8_LDB(B0, 0, 0); PG8_LDB(B1, 0, 1); PG8_SCHED; PG8_LDA(At, 0, 0); PG8_STAGE(PG8_SA(1, 1), a1 + hstepA, voffA);
            PG8_WAIT_V(8); PG8_WAIT_L(0); PG8_BAR; PG8_MMA(0, 0, At, B0); PG8_MMA(0, 1, At, B1); PG8_BAR; PG8_SCHED;
            PG8_LDA(At, 0, 1); PG8_STAGE(PG8_SB(0, 0), b2, voffB); PG8_STAGE(PG8_SB(0, 1), b2 + hstepB, voffB); PG8_STAGE(PG8_SA(0, 0), a2, voffA);
            PG8_WAIT_V(8); PG8_WAIT_L(0); PG8_BAR; PG8_MMA(1, 0, At, B0); PG8_MMA(1, 1, At, B1); PG8_BAR; PG8_SCHED;
            PG8_LDB(B0, 1, 0); PG8_LDB(B1, 1, 1); PG8_SCHED; PG8_LDA(At, 1, 0); PG8_STAGE(PG8_SA(0, 1), a2 + hstepA, voffA);
            PG8_WAIT_V(8); PG8_WAIT_L(0); PG8_BAR; PG8_MMA(0, 0, At, B0); PG8_MMA(0, 1, At, B1); PG8_BAR; PG8_SCHED;
            PG8_LDA(At, 1, 1); PG8_STAGE(PG8_SB(1, 0), b3, voffB); PG8_STAGE(PG8_SB(1, 1), b3 + hstepB, voffB); PG8_STAGE(PG8_SA(1, 0), a3, voffA);
            PG8_WAIT_V(8); PG8_WAIT_L(0); PG8_BAR; PG8_MMA(1, 0, At, B0); PG8_MMA(1, 1, At, B1); PG8_BAR; PG8_SCHED;
        }
        if (wr == 0) PG8_BAR;
        if (E.mode == 2) E.ffn(acc, cur, wr, wc, fr, fq, lane); else E(acc, cur, wr, wc, fr, fq);
        if (!has_next) break;
#pragma unroll
        for (int a = 0; a < 2; ++a)
#pragma unroll
            for (int b = 0; b < 2; ++b)
#pragma unroll
                for (int m = 0; m < 4; ++m)
#pragma unroll
                    for (int n = 0; n < 2; ++n) acc[a][b][m][n] = (f32x4){0.f, 0.f, 0.f, 0.f};
        cur = nxt; cA = nA; cB = nB; ++ui;
        if (wr == 1) PG8_BAR;
    }
    PG8_WAIT_V(0);
    PG8_BAR;
#undef PG8_SA
#undef PG8_SB
#undef PG8_STAGE
#undef PG8_LDA
#undef PG8_LDB
#undef PG8_MMA
#undef PG8_WAIT_V
#undef PG8_WAIT_L
#undef PG8_BAR
#undef PG8_SCHED
}
}

namespace att {
constexpr int NW = 8, QBLK = 32, KVBLK = 64;
constexpr int LDQ = 1536, LDO = 1024;
constexpr int SHM_V = KVBLK * 128 * 2, SHM_K = KVBLK * 272, SHM_KR = KVBLK * 144;
constexpr int OFF_K = 2 * SHM_V, OFF_KR = OFF_K + 2 * SHM_K, OFF_WS = OFF_KR + 2 * SHM_KR, OFF_QR = OFF_WS + NW * 64 * 4, SHM_ATTN = OFF_QR + NW * 4608;
constexpr float THR = 8.f;
#define KSWZ(row, colB) ((row) * 272 + (colB))
#define KRSWZ(row, colB) ((row) * 144 + (colB))
#define SBAR() __builtin_amdgcn_sched_barrier(0)
__device__ __forceinline__ int crow(int r, int hi) { return (r & 3) + 8 * (r >> 2) + 4 * hi; }
__device__ __forceinline__ unsigned cvtpk(float lo, float hi) { return pk2(lo, hi); }

template <int DQK> __device__ __forceinline__ void partialSM(f32x16& p0, f32x16& p1, float& m_reg, float& mn, float& alpha) {
  constexpr float SCALE = (DQK == 192) ? 0.07216878364870322f : (DQK == 64 ? 1.0f : 0.08838834764831845f);
  constexpr float C = SCALE * 1.4426950408889634f;
  float pmax = p0[0];
#pragma unroll
  for (int r = 1; r < 16; ++r) pmax = fmaxf(pmax, p0[r]);
#pragma unroll
  for (int r = 0; r < 16; ++r) pmax = fmaxf(pmax, p1[r]);
  { auto rr = __builtin_amdgcn_permlane32_swap(__float_as_uint(pmax), __float_as_uint(pmax), false, false);
    pmax = fmaxf(__uint_as_float(rr[0]), __uint_as_float(rr[1])); }
  if (__builtin_expect(__all(pmax - m_reg <= THR / SCALE), 1)) { mn = m_reg; alpha = 1.f; }
  else { mn = fmaxf(m_reg, pmax); alpha = __builtin_amdgcn_exp2f((m_reg - mn) * C); m_reg = mn; }
  float mnC = -mn * C;
#pragma unroll
  for (int r = 0; r < 16; ++r) p0[r] = fmaf(p0[r], C, mnC);
#pragma unroll
  for (int r = 0; r < 16; ++r) p1[r] = fmaf(p1[r], C, mnC);
#pragma unroll
  for (int r = 0; r < 16; ++r) p0[r] = __builtin_amdgcn_exp2f(p0[r]);
}
__device__ __forceinline__ void finishSM(f32x16& p0, f32x16& p1, float alpha, float& l_reg, bf16x8& pa0, bf16x8& pa1, bf16x8& pa2, bf16x8& pa3) {
#pragma unroll
  for (int r = 0; r < 16; ++r) p1[r] = __builtin_amdgcn_exp2f(p1[r]);
  float ps = 0;
#pragma unroll
  for (int r = 0; r < 16; ++r) ps += p0[r];
#pragma unroll
  for (int r = 0; r < 16; ++r) ps += p1[r];
  { auto rr = __builtin_amdgcn_permlane32_swap(__float_as_uint(ps), __float_as_uint(ps), false, false);
    ps = __uint_as_float(rr[0]) + __uint_as_float(rr[1]); }
  l_reg = l_reg * alpha + ps;
#define PK4(P, BASE, OUT) do { unsigned a0 = cvtpk(P[BASE + 0], P[BASE + 1]), a1 = cvtpk(P[BASE + 2], P[BASE + 3]);   \
    unsigned b0 = cvtpk(P[BASE + 4], P[BASE + 5]), b1 = cvtpk(P[BASE + 6], P[BASE + 7]);                              \
    auto r0 = __builtin_amdgcn_permlane32_swap(a0, b0, false, false); auto r1 = __builtin_amdgcn_permlane32_swap(a1, b1, false, false); \
    u32x4 w = {r0[0], r1[0], r0[1], r1[1]}; OUT = *reinterpret_cast<bf16x8*>(&w); } while (0)
  PK4(p0, 0, pa0); PK4(p0, 8, pa1); PK4(p1, 0, pa2); PK4(p1, 8, pa3);
#undef PK4
}
template <int DQK> __device__ __forceinline__ void qkt(f32x16& p0, f32x16& p1, const bf16_t* Ks, const char* KRs, const char* QRw, const bf16x8* qr, int r32, int hi) {
  p0 = f32x16{}; p1 = f32x16{};
#pragma unroll
  for (int d0 = 0; d0 < 8; ++d0) { int cb = (d0 * 16 + hi * 8) * 2;
    bf16x8 b0 = *reinterpret_cast<const bf16x8*>((const char*)Ks + KSWZ(r32, cb));
    bf16x8 b1 = *reinterpret_cast<const bf16x8*>((const char*)Ks + KSWZ(32 + r32, cb));
    p0 = __builtin_amdgcn_mfma_f32_32x32x16_bf16(b0, qr[d0], p0, 0, 0, 0);
    p1 = __builtin_amdgcn_mfma_f32_32x32x16_bf16(b1, qr[d0], p1, 0, 0, 0); }
  if constexpr (DQK == 192) {
#pragma unroll
    for (int d0 = 0; d0 < 4; ++d0) { int cb = (d0 * 16 + hi * 8) * 2;
      bf16x8 b0 = *reinterpret_cast<const bf16x8*>(KRs + KRSWZ(r32, cb));
      bf16x8 b1 = *reinterpret_cast<const bf16x8*>(KRs + KRSWZ(32 + r32, cb));
      bf16x8 qx = *reinterpret_cast<const bf16x8*>(QRw + KRSWZ(r32, cb));
      p0 = __builtin_amdgcn_mfma_f32_32x32x16_bf16(b0, qx, p0, 0, 0, 0);
      p1 = __builtin_amdgcn_mfma_f32_32x32x16_bf16(b1, qx, p1, 0, 0, 0); }
  }
}
__device__ __forceinline__ int v_st(int k, int c) { const int kk = (k & ~0xC) | ((k & 4) << 1) | ((k & 8) >> 1); return ((kk >> 3) * 4 + (c >> 5)) * 512 + ((kk & 7) * 32 + (c & 31)) * 2; }
__device__ __forceinline__ int v_rd_base(int lane) { return ((lane & 3) << 3) | (((lane >> 2) & 3) << 6) | (((lane >> 4) & 1) << 5) | (((lane >> 5) & 1) << 8); }
constexpr int v_rd_off(int d0, int ks, int half) { return d0 * 512 + ks * 4096 + half * 2048; }
template <int OFF> __device__ __forceinline__ s16x4 tr_read(int vb) {
  s16x4 r; asm volatile("ds_read_b64_tr_b16 %0, %1 offset:%2" : "=&v"(r) : "v"(vb), "i"(OFF) : "memory"); return r;
}
template <int D0> __device__ __forceinline__ void pv_one(f32x16& od, int vb, bf16x8 pa0, bf16x8 pa1, bf16x8 pa2, bf16x8 pa3) {
  const s16x4 l0 = tr_read<v_rd_off(D0, 0, 0)>(vb), h0 = tr_read<v_rd_off(D0, 0, 1)>(vb), l1 = tr_read<v_rd_off(D0, 1, 0)>(vb), h1 = tr_read<v_rd_off(D0, 1, 1)>(vb);
  const s16x4 l2 = tr_read<v_rd_off(D0, 2, 0)>(vb), h2 = tr_read<v_rd_off(D0, 2, 1)>(vb), l3 = tr_read<v_rd_off(D0, 3, 0)>(vb), h3 = tr_read<v_rd_off(D0, 3, 1)>(vb);
  asm volatile("s_waitcnt lgkmcnt(0)" ::: "memory"); SBAR();
#define PK(L, H) (bf16x8){L[0], L[1], L[2], L[3], H[0], H[1], H[2], H[3]}
  od = __builtin_amdgcn_mfma_f32_32x32x16_bf16(pa0, PK(l0, h0), od, 0, 0, 0);
  od = __builtin_amdgcn_mfma_f32_32x32x16_bf16(pa1, PK(l1, h1), od, 0, 0, 0);
  od = __builtin_amdgcn_mfma_f32_32x32x16_bf16(pa2, PK(l2, h2), od, 0, 0, 0);
  od = __builtin_amdgcn_mfma_f32_32x32x16_bf16(pa3, PK(l3, h3), od, 0, 0, 0);
#undef PK
}
__device__ __forceinline__ void pv_d0(f32x16* o, int vb, bf16x8 pa0, bf16x8 pa1, bf16x8 pa2, bf16x8 pa3) {
  pv_one<0>(o[0], vb, pa0, pa1, pa2, pa3); pv_one<1>(o[1], vb, pa0, pa1, pa2, pa3); pv_one<2>(o[2], vb, pa0, pa1, pa2, pa3); pv_one<3>(o[3], vb, pa0, pa1, pa2, pa3);
}


template <int DQK> __device__ __forceinline__ void pv_partialSM(f32x16* o, int vb, bf16x8 pa0, bf16x8 pa1, bf16x8 pa2, bf16x8 pa3,
                                                                 f32x16& p0, f32x16& p1, float& m_reg, float& alpha) {
  constexpr float SCALE = (DQK == 192) ? 0.07216878364870322f : (DQK == 64 ? 1.0f : 0.08838834764831845f);
  constexpr float C = SCALE * 1.4426950408889634f;
  pv_one<0>(o[0], vb, pa0, pa1, pa2, pa3);
  float pmax = p0[0];
#pragma unroll
  for (int r = 1; r < 16; ++r) pmax = fmaxf(pmax, p0[r]);
  pv_one<1>(o[1], vb, pa0, pa1, pa2, pa3);
#pragma unroll
  for (int r = 0; r < 16; ++r) pmax = fmaxf(pmax, p1[r]);
  { auto rr = __builtin_amdgcn_permlane32_swap(__float_as_uint(pmax), __float_as_uint(pmax), false, false);
    pmax = fmaxf(__uint_as_float(rr[0]), __uint_as_float(rr[1])); }
  const bool keep = __all(pmax - m_reg <= THR / SCALE);
  const float mn = keep ? m_reg : fmaxf(m_reg, pmax);
  alpha = __builtin_amdgcn_exp2f((m_reg - mn) * C); m_reg = mn;
  const float mnC = -mn * C;
  pv_one<2>(o[2], vb, pa0, pa1, pa2, pa3);
#pragma unroll
  for (int r = 0; r < 16; ++r) { p0[r] = fmaf(p0[r], C, mnC); p1[r] = fmaf(p1[r], C, mnC); }
  pv_one<3>(o[3], vb, pa0, pa1, pa2, pa3);
#pragma unroll
  for (int r = 0; r < 16; ++r) p0[r] = __builtin_amdgcn_exp2f(p0[r]);
  asm volatile("" : "+v"(p0), "+v"(p1));
  SBAR();
}

template <int DQK, int LDK>
__device__ __forceinline__ void attn_unit(const bf16_t* __restrict__ Qb, const bf16_t* __restrict__ Kh, const bf16_t* __restrict__ Vh, const bf16_t* __restrict__ Krp,
                                          bf16_t* __restrict__ Ob, int seq, int qpos0, const float* __restrict__ COS, const float* __restrict__ SIN, char* lds) {
  constexpr bool ROPE = (DQK == 192);
  constexpr int NQ = 8;
  int tid_ = threadIdx.x; asm volatile("" : "+v"(tid_));
  const int tid = tid_, wid = __builtin_amdgcn_readfirstlane(tid >> 6), lane = tid & 63, r32 = lane & 31, hi = lane >> 5;
  char* QRw = lds + OFF_QR + wid * 4608;
  bf16_t* V_lds = (bf16_t*)lds; bf16_t* K_lds = (bf16_t*)(lds + OFF_K); char* KR_lds = lds + OFF_KR;
  float* ws = (float*)(lds + OFF_WS) + wid * 64; float* li_l = ws; float* al_l = ws + 32;
  float m_reg = -1e30f, l_reg = 0; f32x16 o[4] = {}; bf16x8 qr[NQ];
  const bf16_t* Qw = Qb + (long)(wid * QBLK + r32) * LDQ + hi * 8;
#pragma unroll
  for (int d0 = 0; d0 < NQ; ++d0) qr[d0] = *reinterpret_cast<const bf16x8*>(Qw + d0 * 16);
  if constexpr (ROPE) {
    const int pos = qpos0 + wid * QBLK + r32;
#pragma unroll
    for (int d = 0; d < 2; ++d) {
      const float* cp = COS + pos * 32 + d * 16 + hi * 8; const float* sp = SIN + pos * 32 + d * 16 + hi * 8;
      const f32x4 c0 = *(const f32x4*)cp, c1 = *(const f32x4*)(cp + 4), s0 = *(const f32x4*)sp, s1 = *(const f32x4*)(sp + 4);
      const bf16x8 a = *reinterpret_cast<const bf16x8*>(Qw + (8 + d) * 16), b = *reinterpret_cast<const bf16x8*>(Qw + (10 + d) * 16);
      float y1[8], y2[8];
#pragma unroll
      for (int e = 0; e < 8; ++e) { const float c = e < 4 ? c0[e & 3] : c1[e & 3], s = e < 4 ? s0[e & 3] : s1[e & 3];
        const float x1 = __uint_as_float(((unsigned)(unsigned short)a[e]) << 16), x2 = __uint_as_float(((unsigned)(unsigned short)b[e]) << 16);
        y1[e] = x1 * c - x2 * s; y2[e] = x2 * c + x1 * s; }
      u32x4 wa = {pk2(y1[0], y1[1]), pk2(y1[2], y1[3]), pk2(y1[4], y1[5]), pk2(y1[6], y1[7])};
      u32x4 wb = {pk2(y2[0], y2[1]), pk2(y2[2], y2[3]), pk2(y2[4], y2[5]), pk2(y2[6], y2[7])};
      *(u32x4*)(QRw + KRSWZ(r32, (d * 16 + hi * 8) * 2)) = wa; *(u32x4*)(QRw + KRSWZ(r32, (32 + d * 16 + hi * 8) * 2)) = wb;
    }
  }
  const int sr = tid >> 4, sc = (tid & 15) * 8, vst0 = v_st(sr, sc), vst1 = v_st(32 + sr, sc);
  const int krr = tid >> 3, krc = (tid & 7) * 8;
  const int vb0 = (int)(uintptr_t)V_lds + v_rd_base(lane);
  constexpr int SD = ROPE ? 1 : 2;
  struct { bf16x8 vs0, vs1, ks0, ks1, kr; } sr_[SD];
#define SLOAD(i, k0) do { sr_[i].vs0 = *(const bf16x8*)(&Vh[(long)((k0) + sr) * LDK + sc]); sr_[i].vs1 = *(const bf16x8*)(&Vh[(long)((k0) + 32 + sr) * LDK + sc]); \
    sr_[i].ks0 = *(const bf16x8*)(&Kh[(long)((k0) + sr) * LDK + sc]); sr_[i].ks1 = *(const bf16x8*)(&Kh[(long)((k0) + 32 + sr) * LDK + sc]); \
    if constexpr (ROPE) sr_[i].kr = *(const bf16x8*)(&Krp[(long)((k0) + krr) * 64 + krc]); } while (0)
#define SWRITE(b, i) do { *(bf16x8*)((char*)V_lds + (b) * SHM_V + vst0) = sr_[i].vs0;          \
    *(bf16x8*)((char*)V_lds + (b) * SHM_V + vst1) = sr_[i].vs1; int kc = sc * 2;               \
    *(bf16x8*)((char*)K_lds + (b) * SHM_K + KSWZ(sr, kc)) = sr_[i].ks0;                       \
    *(bf16x8*)((char*)K_lds + (b) * SHM_K + KSWZ(32 + sr, kc)) = sr_[i].ks1;                  \
    if constexpr (ROPE) *(bf16x8*)(KR_lds + (b) * SHM_KR + KRSWZ(krr, krc * 2)) = sr_[i].kr; } while (0)
#define SWAIT() do { if constexpr (SD == 1) asm volatile("s_waitcnt vmcnt(0)" ::: "memory"); else asm volatile("s_waitcnt vmcnt(4)" ::: "memory"); } while (0)
#define RESC(a) do { if (__any((a) < 1.f)) { if (hi == 0) al_l[r32] = (a); asm volatile("s_waitcnt lgkmcnt(0)" ::: "memory"); \
    _Pragma("unroll") for (int d = 0; d < 4; ++d) _Pragma("unroll") for (int r = 0; r < 16; ++r) o[d][r] *= al_l[crow(r, hi)]; } } while (0)
  f32x16 pA0, pA1, pB0, pB1; float mnA, mnB, alA, alB; bf16x8 pa0, pa1, pa2, pa3; const int NT = seq / KVBLK;
  constexpr int SE = 0, SO = SD - 1;
  SLOAD(SE, 0); asm volatile("s_waitcnt vmcnt(0)" ::: "memory"); SWRITE(0, SE); __syncthreads();
  qkt<DQK>(pA0, pA1, K_lds, KR_lds, QRw, qr, r32, hi); partialSM<DQK>(pA0, pA1, m_reg, mnA, alA);
  SLOAD(SO, KVBLK); if constexpr (SD == 2) { if (2 < NT) SLOAD(SE, 2 * KVBLK); }
  SWAIT(); SWRITE(1, SO); __syncthreads();
  for (int j = 1; j + 1 < NT; j += 2) {
    SBAR(); qkt<DQK>(pB0, pB1, (bf16_t*)((char*)K_lds + SHM_K), KR_lds + SHM_KR, QRw, qr, r32, hi);
    finishSM(pA0, pA1, alA, l_reg, pa0, pa1, pa2, pa3); SBAR();
    SLOAD(SO, (j + SD) * KVBLK); SBAR();
    pv_partialSM<DQK>(o, vb0, pa0, pa1, pa2, pa3, pB0, pB1, m_reg, alB);
    __syncthreads(); SWAIT(); SWRITE(0, SE);
    RESC(alB); __syncthreads();
    SBAR(); qkt<DQK>(pA0, pA1, K_lds, KR_lds, QRw, qr, r32, hi);
    finishSM(pB0, pB1, alB, l_reg, pa0, pa1, pa2, pa3); SBAR();
    if (SD == 1 || j + 3 < NT) SLOAD(SE, (j + 1 + SD) * KVBLK); SBAR();
    pv_partialSM<DQK>(o, vb0 + (int)SHM_V, pa0, pa1, pa2, pa3, pA0, pA1, m_reg, alA);
    __syncthreads(); SWAIT(); SWRITE(1, SO);
    RESC(alA); __syncthreads();
  }
  SBAR(); qkt<DQK>(pB0, pB1, (bf16_t*)((char*)K_lds + SHM_K), KR_lds + SHM_KR, QRw, qr, r32, hi);
  finishSM(pA0, pA1, alA, l_reg, pa0, pa1, pa2, pa3); SBAR();
  pv_partialSM<DQK>(o, vb0, pa0, pa1, pa2, pa3, pB0, pB1, m_reg, alB);
  __syncthreads(); RESC(alB);
  finishSM(pB0, pB1, alB, l_reg, pa0, pa1, pa2, pa3); SBAR();
  pv_d0(o, vb0 + (int)SHM_V, pa0, pa1, pa2, pa3);
  if (hi == 0) li_l[r32] = l_reg; asm volatile("s_waitcnt lgkmcnt(0)" ::: "memory");
  float rli[16];
#pragma unroll
  for (int r = 0; r < 16; ++r) rli[r] = __builtin_amdgcn_rcpf(li_l[crow(r, hi)]);
  bf16_t* Ow = Ob + (long)(wid * QBLK) * LDO;
#pragma unroll
  for (int r = 0; r < 16; ++r) { int orow = crow(r, hi);
#pragma unroll
    for (int d0 = 0; d0 < 4; ++d0) Ow[(long)orow * LDO + d0 * 32 + r32] = (bf16_t)(pk2(o[d0][r] * rli[r], 0.f) & 0xffffu); }
  __syncthreads();
#undef SLOAD
#undef SWRITE
#undef SWAIT
#undef RESC
}
}

namespace na {
constexpr int KROW = 9232, KEYB = 144, VOFF = 8 * KROW;
__device__ __forceinline__ float dot2(unsigned a, unsigned b, float c) { return __builtin_amdgcn_fdot2_f32_bf16(__builtin_bit_cast(bf16x2_t, a), __builtin_bit_cast(bf16x2_t, b), c, false); }
__device__ __forceinline__ void na_unit(const bf16_t* __restrict__ QKV, bf16_t* __restrict__ O, const float* __restrict__ rpb, int tok0, int rows, int r, int h, LAS unsigned char* lds, const int tid) {
  const int r0 = min(max(r - 4, 0), rows - 8);
  const bf16_t* kbase = QKV + (size_t)(tok0 + r0 * 64) * 3072 + 1024 + h * 64;
#pragma unroll
  for (int i = 0; i < 8; ++i) { const int id = i * 512 + tid, key = id >> 3, part = id & 7;
    const u32x4 kv = *(const u32x4*)(kbase + (size_t)key * 3072 + part * 8); const u32x4 vv = *(const u32x4*)(kbase + 1024 + (size_t)key * 3072 + part * 8);
    const int off = (key >> 6) * KROW + (key & 63) * KEYB + part * 16;
    *(LAS u32x4*)(lds + off) = kv; *(LAS u32x4*)(lds + VOFF + off) = vv; }
  const int c = tid >> 3, p = tid & 7;
  const bf16_t* qp = QKV + (size_t)(tok0 + r * 64 + c) * 3072 + h * 64;
  u32x4 q[8];
#pragma unroll
  for (int k = 0; k < 8; ++k) q[k] = *(const u32x4*)(qp + k * 8);
  __syncthreads();
  const int c0 = min(max(c - 8, 0), 48);
  const int kb = p * KROW + c0 * KEYB;
  const float* bp = rpb + (h * 15 + (r0 + p - r + 7)) * 31 + (c0 - c + 15);
  float mx = -1e30f;
#pragma unroll 1
  for (int j = 0; j < 16; ++j) { float s = 0.f;
#pragma unroll
    for (int k = 0; k < 8; ++k) { const u32x4 kv = *(const LAS u32x4*)(lds + kb + j * KEYB + k * 16);
      s = dot2(q[k].x, kv.x, s); s = dot2(q[k].y, kv.y, s); s = dot2(q[k].z, kv.z, s); s = dot2(q[k].w, kv.w, s); }
    mx = fmaxf(mx, s * 0.125f + bp[j]); }
  mx = fmaxf(mx, __shfl_xor(mx, 1)); mx = fmaxf(mx, __shfl_xor(mx, 2)); mx = fmaxf(mx, __shfl_xor(mx, 4));
  float l = 0.f;
  float o[64];
#pragma unroll
  for (int d = 0; d < 64; ++d) o[d] = 0.f;
#pragma unroll 1
  for (int j = 0; j < 16; ++j) { float s = 0.f;
#pragma unroll
    for (int k = 0; k < 8; ++k) { const u32x4 kv = *(const LAS u32x4*)(lds + kb + j * KEYB + k * 16);
      s = dot2(q[k].x, kv.x, s); s = dot2(q[k].y, kv.y, s); s = dot2(q[k].z, kv.z, s); s = dot2(q[k].w, kv.w, s); }
    const float pj = __builtin_amdgcn_exp2f((s * 0.125f + bp[j] - mx) * 1.4426950408889634f); l += pj;
#pragma unroll
    for (int k = 0; k < 8; ++k) { const u32x4 vv = *(const LAS u32x4*)(lds + VOFF + kb + j * KEYB + k * 16);
      o[8 * k + 0] += pj * bflo(vv.x); o[8 * k + 1] += pj * bfhi(vv.x); o[8 * k + 2] += pj * bflo(vv.y); o[8 * k + 3] += pj * bfhi(vv.y);
      o[8 * k + 4] += pj * bflo(vv.z); o[8 * k + 5] += pj * bfhi(vv.z); o[8 * k + 6] += pj * bflo(vv.w); o[8 * k + 7] += pj * bfhi(vv.w); } }
  l += __shfl_xor(l, 1); l += __shfl_xor(l, 2); l += __shfl_xor(l, 4);
  const bool b2 = (p & 4) != 0, b1 = (p & 2) != 0, b0 = (p & 1) != 0;
  float o1[32];
#pragma unroll
  for (int i = 0; i < 32; ++i) { const float snd = b2 ? o[i] : o[i + 32], keep = b2 ? o[i + 32] : o[i]; o1[i] = keep + __shfl_xor(snd, 4); }
  float o2[16];
#pragma unroll
  for (int i = 0; i < 16; ++i) { const float snd = b1 ? o1[i] : o1[i + 16], keep = b1 ? o1[i + 16] : o1[i]; o2[i] = keep + __shfl_xor(snd, 2); }
  float o3[8];
#pragma unroll
  for (int i = 0; i < 8; ++i) { const float snd = b0 ? o2[i] : o2[i + 8], keep = b0 ? o2[i + 8] : o2[i]; o3[i] = keep + __shfl_xor(snd, 1); }
  const float rl = __builtin_amdgcn_rcpf(l);
  u32x4 w; w.x = pk2(o3[0] * rl, o3[1] * rl); w.y = pk2(o3[2] * rl, o3[3] * rl); w.z = pk2(o3[4] * rl, o3[5] * rl); w.w = pk2(o3[6] * rl, o3[7] * rl);
  *(u32x4*)(O + (size_t)(tok0 + r * 64 + c) * 1024 + h * 64 + p * 8) = w;
  __syncthreads();
}
}


namespace na2 {
constexpr int OFF_V = 0, OFF_K = 32768, SHM_K = 64 * 144, OFF_T = OFF_K + 2 * SHM_K, OFF_WS = OFF_T + 15 * 128 * 4, NA_LDS = OFF_WS + 8 * 64 * 4;
__device__ __forceinline__ void na_unit(const bf16_t* __restrict__ QKV, bf16_t* __restrict__ O, const float* __restrict__ rpb, int tok0, int rows, int g4, int h, char* lds) {
  using namespace att;
  int tid_ = threadIdx.x; asm volatile("" : "+v"(tid_));
  const int tid = tid_, wid = __builtin_amdgcn_readfirstlane(tid >> 6), lane = tid & 63, r32 = lane & 31, hi = lane >> 5;
  const int qr = 4 * g4 + (wid >> 1), qh = wid & 1, c = 32 * qh + r32;
  const int krlo = min(max(4 * g4 - 4, 0), rows - 8), krhi = min(max(4 * g4 - 1, 0), rows - 8) + 7, nt = krhi - krlo + 1;
  const int r0w = min(max(qr - 4, 0), rows - 8), c0 = min(max(c - 8, 0), 48);
  float* T = (float*)(lds + OFF_T); float* ws = (float*)(lds + OFF_WS) + wid * 64; float* li_l = ws; float* al_l = ws + 32;
  if (tid < 465) { const int rr = tid / 31, cc = tid - rr * 31; T[rr * 128 + 48 + cc] = rpb[h * 465 + tid]; }
  bf16x8 qf[4];
  { const bf16_t* qp = QKV + (size_t)(tok0 + qr * 64 + c) * 3072 + h * 64 + hi * 8;
#pragma unroll
    for (int d0 = 0; d0 < 4; ++d0) qf[d0] = *reinterpret_cast<const bf16x8*>(qp + d0 * 16); }
  const int skey = tid >> 3, sch = tid & 7;
  const bf16_t* kg = QKV + (size_t)(tok0 + krlo * 64 + skey) * 3072 + 1024 + h * 64 + sch * 8;
  const int kst = skey * 144 + sch * 16, vst = v_st(skey, sch * 8);
  const int vb0 = (int)(uintptr_t)(lds + OFF_V) + v_rd_base(lane);
  bf16x8 sk, sv;
  sk = *(const bf16x8*)kg; sv = *(const bf16x8*)(kg + 1024);
  asm volatile("s_waitcnt vmcnt(0)" ::: "memory");
  *(bf16x8*)(lds + OFF_K + kst) = sk; *(bf16x8*)(lds + OFF_V + vst) = sv;
  __syncthreads();
  float m_reg = -1e30f, l_reg = 0.f; f32x16 o[2] = {};
  const int tb = (48 - c + 15 + 4 * hi);
  for (int t = 0; t < nt; ++t) {
    const int buf = t & 1, kr = krlo + t;
    if (t + 1 < nt) { sk = *(const bf16x8*)(kg + (size_t)(t + 1) * 64 * 3072); sv = *(const bf16x8*)(kg + (size_t)(t + 1) * 64 * 3072 + 1024); }
    if (kr >= r0w && kr <= r0w + 7) {
      const char* Ks = lds + OFF_K + buf * SHM_K;
      f32x16 p0 = {}, p1 = {};
#pragma unroll
      for (int d0 = 0; d0 < 4; ++d0) { const int cb = (d0 * 16 + hi * 8) * 2;
        const bf16x8 b0 = *reinterpret_cast<const bf16x8*>(Ks + r32 * 144 + cb), b1 = *reinterpret_cast<const bf16x8*>(Ks + (32 + r32) * 144 + cb);
        p0 = __builtin_amdgcn_mfma_f32_32x32x16_bf16(b0, qf[d0], p0, 0, 0, 0); p1 = __builtin_amdgcn_mfma_f32_32x32x16_bf16(b1, qf[d0], p1, 0, 0, 0); }
      const float* Tr = T + (kr - qr + 7) * 128 + tb;
#pragma unroll
      for (int r = 0; r < 16; ++r) { const int ko = (r & 3) + 8 * (r >> 2), kc = ko + 4 * hi;
        const bool v0 = (kc >= c0) && (kc <= c0 + 15), v1 = (kc + 32 >= c0) && (kc + 32 <= c0 + 15);
        p0[r] = v0 ? fmaf(p0[r], 0.125f, Tr[ko]) : -1e30f; p1[r] = v1 ? fmaf(p1[r], 0.125f, Tr[ko + 32]) : -1e30f; }
      float mn, al; bf16x8 pa0, pa1, pa2, pa3;
      partialSM<64>(p0, p1, m_reg, mn, al);
      finishSM(p0, p1, al, l_reg, pa0, pa1, pa2, pa3);
      if (__any(al < 1.f)) { if (hi == 0) al_l[r32] = al; asm volatile("s_waitcnt lgkmcnt(0)" ::: "memory");
#pragma unroll
        for (int d = 0; d < 2; ++d)
#pragma unroll
          for (int r = 0; r < 16; ++r) o[d][r] *= al_l[crow(r, hi)]; }
      const int vb = vb0 + buf * 16384;
      pv_one<0>(o[0], vb, pa0, pa1, pa2, pa3); pv_one<1>(o[1], vb, pa0, pa1, pa2, pa3);
    }
    if (t + 1 < nt) { *(bf16x8*)(lds + OFF_K + (buf ^ 1) * SHM_K + kst) = sk; *(bf16x8*)(lds + OFF_V + (buf ^ 1) * 16384 + vst) = sv; }
    __syncthreads();
  }
  if (hi == 0) li_l[r32] = l_reg; asm volatile("s_waitcnt lgkmcnt(0)" ::: "memory");
  bf16_t* Ow = O + (size_t)(tok0 + qr * 64 + 32 * qh) * 1024 + h * 64;
#pragma unroll
  for (int r = 0; r < 16; ++r) { const int orow = crow(r, hi); const float rl = __builtin_amdgcn_rcpf(li_l[orow]);
#pragma unroll
    for (int d0 = 0; d0 < 2; ++d0) Ow[(size_t)orow * 1024 + d0 * 32 + r32] = (bf16_t)(pk2(o[d0][r] * rl, 0.f) & 0xffffu); }
  __syncthreads();
}
}

__device__ __forceinline__ void transpose_item(const float* __restrict__ W, int K, int N, bf16_t* __restrict__ WT, LAS float* scr, int item, int lane, bool ffn_remap = false) {
    const int nblk = N / 32, kb = item / nblk, nb = item % nblk, k0 = 64 * kb, n0 = 32 * nb;
    const int d0 = !ffn_remap ? n0 : (n0 < 4096 ? (n0 >> 7) * 256 + (n0 & 127) : ((n0 - 4096) >> 7) * 256 + 128 + (n0 & 127));
#pragma unroll 8
    for (int i = 0; i < 32; ++i) { const int kk = 2 * i + (lane >> 5); scr[kk * 33 + (lane & 31)] = W[(size_t)(k0 + kk) * N + n0 + (lane & 31)]; }
    asm volatile("s_waitcnt lgkmcnt(0)" ::: "memory");
    const int c = lane & 7;
#pragma unroll
    for (int j = 0; j < 4; ++j) { const int n = (lane >> 3) + 8 * j; const LAS float* s = scr + (8 * c) * 33 + n;
        u32x4 o; o.x = pk2(s[0 * 33], s[1 * 33]); o.y = pk2(s[2 * 33], s[3 * 33]); o.z = pk2(s[4 * 33], s[5 * 33]); o.w = pk2(s[6 * 33], s[7 * 33]);
        *(u32x4*)(WT + (size_t)(d0 + n) * K + k0 + 8 * c) = o; }
    asm volatile("s_waitcnt lgkmcnt(0)" ::: "memory");
}

struct Args { const float* in[28]; float* out; unsigned char* ws; };
typedef const __attribute__((address_space(4))) Args* CArgs;

__device__ __forceinline__ void conv_layer(CArgs a, int L, LAS unsigned char* lds, int gw, int NGW, int lane, int wave, int gtid, int ngt) {
    LAS float* scr = (LAS float*)(lds + wave * 16384);
    unsigned char* wb = a->ws + WS_WB;
    const int kind = L % 3, j = L / 3;
    const float* w_in = a->in[21] + (size_t)L * DM * 2 * FF; const float* w_out = a->in[24] + (size_t)L * FF * DM;
    const float* w_gate = a->in[26] + (size_t)L * DM * DM; const float* w_proj = a->in[25] + (size_t)L * PLE * DM;
    constexpr int I_IN = 16 * 256, I_OUT = 64 * 32, I_GATE = 16 * 32, I_PROJ = 4 * 32, I_O = 16 * 32;
    const float* m1; int m1N; const float* wo;
    if (kind == 0) { m1 = a->in[8] + (size_t)j * DM * 704; m1N = 704; wo = a->in[13] + (size_t)j * DM * DM; }
    else if (kind == 1) { m1 = a->in[14] + (size_t)j * DM * 1536; m1N = 1536; wo = a->in[17] + (size_t)j * DM * DM; }
    else { m1 = a->in[18] + (size_t)j * DM * 3072; m1N = 3072; wo = a->in[20] + (size_t)j * DM * DM; }
    const int I_M1 = 16 * (m1N / 32);
    const int I_UQ = (kind == 0) ? 6 * 48 : 0, I_UKV = (kind == 0) ? 4 * 64 : 0, I_PAD = (kind == 0) ? 128 : 0;
    const int NITEMS = I_IN + I_OUT + I_GATE + I_PROJ + I_O + I_M1 + I_UQ + I_UKV + I_PAD;
    for (int it = gw; it < NITEMS; it += NGW) {
        int r = it;
        if (r < I_IN) { transpose_item(w_in, DM, 2 * FF, (bf16_t*)(wb + WB_IN), scr, r, lane, true); continue; } r -= I_IN;
        if (r < I_OUT) { transpose_item(w_out, FF, DM, (bf16_t*)(wb + WB_OUT), scr, r, lane); continue; } r -= I_OUT;
        if (r < I_GATE) { transpose_item(w_gate, DM, DM, (bf16_t*)(wb + WB_GATE), scr, r, lane); continue; } r -= I_GATE;
        if (r < I_PROJ) { transpose_item(w_proj, PLE, DM, (bf16_t*)(wb + WB_PROJ), scr, r, lane); continue; } r -= I_PROJ;
        if (r < I_O) { transpose_item(wo, DM, DM, (bf16_t*)(wb + WB_O), scr, r, lane); continue; } r -= I_O;
        if (r < I_M1) { transpose_item(m1, DM, m1N, (bf16_t*)(wb + WB_MIX1), scr, r, lane); continue; } r -= I_M1;
        if (r < I_UQ) { transpose_item(a->in[11] + (size_t)j * 384 * 1536, 384, 1536, (bf16_t*)(wb + WB_UQ), scr, r, lane); continue; } r -= I_UQ;
        if (r < I_UKV) { transpose_item(a->in[12] + (size_t)j * 256 * 2048, 256, 2048, (bf16_t*)(wb + WB_UKV), scr, r, lane); continue; } r -= I_UKV;
        { unsigned z = 0u; asm volatile("" : "+v"(z));
          *(u32x4*)(wb + WB_MIX1 + (size_t)704 * 1024 * 2 + (size_t)r * 1024 + lane * 16) = (u32x4){z, z, z, z}; }
    }
    const float* pp = a->in[2] + (size_t)L * HTOK * PLE; const float* ps = a->in[3] + (size_t)L * HTOK * PLE;
    bf16_t* pb = (bf16_t*)(a->ws + WS_PB);
    constexpr int NP8 = NTOK * PLE / 8, HP8 = HTOK * PLE / 8;
    for (int i = gtid; i < NP8; i += ngt) {
        const float* src = (i < HP8) ? pp + (size_t)i * 8 : ps + (size_t)(i - HP8) * 8;
        const f32x4 x0 = *(const f32x4*)src, x1 = *(const f32x4*)(src + 4);
        u32x4 w; w.x = pk2(x0[0], x0[1]); w.y = pk2(x0[2], x0[3]); w.z = pk2(x1[0], x1[1]); w.w = pk2(x1[2], x1[3]);
        *(u32x4*)(pb + (size_t)i * 8) = w;
    }
}

__device__ __forceinline__ void rowpass(CArgs a, int gw, int NGW, int lane, bool init, const bf16_t* __restrict__ src, const float* __restrict__ gadd,
                                        bool has_out, const float* __restrict__ gout, bf16_t* __restrict__ out) {
    constexpr int RP = 4;
    float* X = a->out;
    for (int m0 = gw * RP; m0 < NTOK; m0 += NGW * RP) {
        f32x4 v[RP][4]; u32x2 sv[RP][4];
#pragma unroll
        for (int q = 0; q < RP; ++q) { const int m = m0 + q;
            const float* xin = init ? (m < HTOK ? a->in[0] + (size_t)m * DM : a->in[1] + (size_t)(m - HTOK) * DM) : X + (size_t)m * DM;
#pragma unroll
            for (int j = 0; j < 4; ++j) v[q][j] = *(const f32x4*)(xin + lane * 4 + 256 * j);
            if (src) {
#pragma unroll
                for (int j = 0; j < 4; ++j) sv[q][j] = *(const u32x2*)(src + (size_t)m * DM + lane * 4 + 256 * j);
            } }
        if (src) {
            float ss[RP];
#pragma unroll
            for (int q = 0; q < RP; ++q) { ss[q] = 0.f;
#pragma unroll
                for (int j = 0; j < 4; ++j) { const float s0 = bflo(sv[q][j].x), s1 = bfhi(sv[q][j].x), s2 = bflo(sv[q][j].y), s3 = bfhi(sv[q][j].y); ss[q] += (s0 * s0 + s1 * s1) + (s2 * s2 + s3 * s3); } }
#pragma unroll
            for (int o = 1; o < 64; o <<= 1) {
#pragma unroll
                for (int q = 0; q < RP; ++q) ss[q] += __shfl_xor(ss[q], o); }
#pragma unroll
            for (int j = 0; j < 4; ++j) { const f32x4 g = *(const f32x4*)(gadd + lane * 4 + 256 * j);
#pragma unroll
                for (int q = 0; q < RP; ++q) { const float rs = rsqrtf(ss[q] * (1.f / DM) + EPS);
                    v[q][j][0] += bflo(sv[q][j].x) * rs * g[0]; v[q][j][1] += bfhi(sv[q][j].x) * rs * g[1]; v[q][j][2] += bflo(sv[q][j].y) * rs * g[2]; v[q][j][3] += bfhi(sv[q][j].y) * rs * g[3]; } }
        }
        if (src || init) {
#pragma unroll
            for (int q = 0; q < RP; ++q)
#pragma unroll
                for (int j = 0; j < 4; ++j) *(f32x4*)(X + (size_t)(m0 + q) * DM + lane * 4 + 256 * j) = v[q][j];
        }
        if (has_out) {
            float s2[RP];
#pragma unroll
            for (int q = 0; q < RP; ++q) { s2[q] = 0.f;
#pragma unroll
                for (int j = 0; j < 4; ++j) s2[q] += (v[q][j][0] * v[q][j][0] + v[q][j][1] * v[q][j][1]) + (v[q][j][2] * v[q][j][2] + v[q][j][3] * v[q][j][3]); }
#pragma unroll
            for (int o = 1; o < 64; o <<= 1) {
#pragma unroll
                for (int q = 0; q < RP; ++q) s2[q] += __shfl_xor(s2[q], o); }
#pragma unroll
            for (int j = 0; j < 4; ++j) { f32x4 g = (f32x4){1.f, 1.f, 1.f, 1.f}; if (gout) g = *(const f32x4*)(gout + lane * 4 + 256 * j);
#pragma unroll
                for (int q = 0; q < RP; ++q) { const float r2 = rsqrtf(s2[q] * (1.f / DM) + EPS);
                    u32x2 w; w.x = pk2(v[q][j][0] * r2 * g[0], v[q][j][1] * r2 * g[1]); w.y = pk2(v[q][j][2] * r2 * g[2], v[q][j][3] * r2 * g[3]);
                    *(u32x2*)(out + (size_t)(m0 + q) * DM + lane * 4 + 256 * j) = w; } }
        }
    }
}

__device__ __forceinline__ int tok_pos(int m) { return m < HTOK ? (m & 2047) : (m & 8191); }

__device__ __forceinline__ void mla_c(CArgs a, int jl, int gw, int NGW, int lane) {
    const bf16_t* DOWN = (const bf16_t*)(a->ws + WS_R + R_DOWN); bf16_t* CQ = (bf16_t*)(a->ws + WS_R + R_CQ); bf16_t* CKV = (bf16_t*)(a->ws + WS_R + R_CKV); bf16_t* KR = (bf16_t*)(a->ws + WS_R + R_KROPE);
    const float* qn = a->in[9] + jl * 384; const float* kvn = a->in[10] + jl * 256;
    const float* COS = (const float*)(a->ws + WS_COS); const float* SIN = (const float*)(a->ws + WS_SIN);
    for (int m = gw; m < NTOK; m += NGW) {
        const bf16_t* d = DOWN + (size_t)m * 768;
        unsigned qv[3]; float ss = 0.f;
#pragma unroll
        for (int j = 0; j < 3; ++j) { qv[j] = *(const unsigned*)(d + 2 * lane + 128 * j); const float x0 = bflo(qv[j]), x1 = bfhi(qv[j]); ss += x0 * x0 + x1 * x1; }
        const float rq = rsqrtf(wave_sum(ss) * (1.f / 384.f) + EPS);
#pragma unroll
        for (int j = 0; j < 3; ++j) { const int c = 2 * lane + 128 * j; *(unsigned*)(CQ + (size_t)m * 384 + c) = pk2(bflo(qv[j]) * rq * qn[c], bfhi(qv[j]) * rq * qn[c + 1]); }
        const u32x2 kv = *(const u32x2*)(d + 384 + 4 * lane);
        const float k0 = bflo(kv.x), k1 = bfhi(kv.x), k2 = bflo(kv.y), k3 = bfhi(kv.y);
        const float rk = rsqrtf(wave_sum((k0 * k0 + k1 * k1) + (k2 * k2 + k3 * k3)) * (1.f / 256.f) + EPS);
        const f32x4 g = *(const f32x4*)(kvn + 4 * lane);
        u32x2 w; w.x = pk2(k0 * rk * g[0], k1 * rk * g[1]); w.y = pk2(k2 * rk * g[2], k3 * rk * g[3]);
        *(u32x2*)(CKV + (size_t)m * 256 + 4 * lane) = w;
        const float x = __uint_as_float(((unsigned)d[640 + lane]) << 16);
        const float other = __shfl_xor(x, 32);
        const int pos = tok_pos(m), i = lane & 31;
        const float c = COS[pos * 32 + i], s = SIN[pos * 32 + i];
        const float y = (lane < 32) ? (x * c - other * s) : (x * c + other * s);
        KR[(size_t)m * 64 + lane] = (bf16_t)(pk2(y, 0.f) & 0xffffu);
    }
}

__device__ __forceinline__ void gqa_c(CArgs a, int jl, int gw, int NGW, int lane) {
    bf16_t* QKV = (bf16_t*)(a->ws + WS_R + R_Q);
    const float* qn = a->in[15] + jl * 128; const float* kn = a->in[16] + jl * 128;
    const float* COS = (const float*)(a->ws + WS_COS); const float* SIN = (const float*)(a->ws + WS_SIN);
    const int sub = lane >> 3, part = lane & 7, half = part >> 2, chunk = part & 3;
    for (int m = gw; m < NTOK; m += NGW) {
        const int t = tok_pos(m); const int pos = half == 0 ? (t >> 6) : (t & 63);
        const float* cp = COS + pos * 32 + chunk * 8; const float* sp = SIN + pos * 32 + chunk * 8;
        const f32x4 c0 = *(const f32x4*)cp, c1 = *(const f32x4*)(cp + 4), s0 = *(const f32x4*)sp, s1 = *(const f32x4*)(sp + 4);
#pragma unroll
        for (int pass = 0; pass < 2; ++pass) {
            const int head = pass * 8 + sub; const bool act = head < 10;
            const int hh = act ? head : 0;
            bf16_t* p1 = QKV + (size_t)m * 1536 + hh * 128 + half * 64 + chunk * 8; bf16_t* p2 = p1 + 32;
            const u32x4 a1 = *(const u32x4*)p1, a2 = *(const u32x4*)p2;
            float x1[8] = {bflo(a1.x), bfhi(a1.x), bflo(a1.y), bfhi(a1.y), bflo(a1.z), bfhi(a1.z), bflo(a1.w), bfhi(a1.w)};
            float x2[8] = {bflo(a2.x), bfhi(a2.x), bflo(a2.y), bfhi(a2.y), bflo(a2.z), bfhi(a2.z), bflo(a2.w), bfhi(a2.w)};
            float ss = 0.f;
#pragma unroll
            for (int e = 0; e < 8; ++e) ss += x1[e] * x1[e] + x2[e] * x2[e];
            ss += __shfl_xor(ss, 1); ss += __shfl_xor(ss, 2); ss += __shfl_xor(ss, 4);
            const float rn = rsqrtf(ss * (1.f / 128.f) + EPS);
            const float* gn = (hh < 8 ? qn : kn) + half * 64 + chunk * 8;
            const f32x4 g10 = *(const f32x4*)gn, g11 = *(const f32x4*)(gn + 4), g20 = *(const f32x4*)(gn + 32), g21 = *(const f32x4*)(gn + 36);
            float y1[8], y2[8];
#pragma unroll
            for (int e = 0; e < 8; ++e) { const float c = e < 4 ? c0[e & 3] : c1[e & 3], s = e < 4 ? s0[e & 3] : s1[e & 3];
                const float g1 = e < 4 ? g10[e & 3] : g11[e & 3], g2 = e < 4 ? g20[e & 3] : g21[e & 3];
                const float u1 = x1[e] * rn * g1, u2 = x2[e] * rn * g2; y1[e] = u1 * c - u2 * s; y2[e] = u2 * c + u1 * s; }
            if (act) {
                u32x4 w1 = {pk2(y1[0], y1[1]), pk2(y1[2], y1[3]), pk2(y1[4], y1[5]), pk2(y1[6], y1[7])};
                u32x4 w2 = {pk2(y2[0], y2[1]), pk2(y2[2], y2[3]), pk2(y2[4], y2[5]), pk2(y2[6], y2[7])};
                *(u32x4*)p1 = w1; *(u32x4*)p2 = w2;
            }
        }
    }
}

__device__ __forceinline__ void act_pass(CArgs a, int L, int h, int gtid, int ngt) {
    bf16_t* GU = (bf16_t*)(a->ws + WS_R + R_GU);
    const float* cw = a->in[22] + (size_t)L * 3 * FF; const float* cb = a->in[23] + (size_t)L * FF;
    const int seqm = h == 0 ? 2047 : 8191;
    constexpr int NIT = HTOK * (FF / 8);
    for (int it = gtid; it < NIT; it += ngt) {
        const int t = it >> 9, c = (it & 511) * 8;
        const int pos = t & seqm;
        bf16_t* gp = GU + (size_t)t * 8192 + c;
        const u32x4 z = (u32x4){0u, 0u, 0u, 0u};
        const u32x4 gc = *(const u32x4*)gp;
        const u32x4 gm = pos == 0 ? z : *(const u32x4*)(gp - 8192);
        const u32x4 gn = pos == seqm ? z : *(const u32x4*)(gp + 8192);
        const u32x4 uu = *(const u32x4*)(gp + 4096);
        float w0[8], w1[8], w2[8], bb[8];
        { const f32x4 x0 = *(const f32x4*)(cw + c), x1 = *(const f32x4*)(cw + c + 4), y0 = *(const f32x4*)(cw + FF + c), y1 = *(const f32x4*)(cw + FF + c + 4);
          const f32x4 z0 = *(const f32x4*)(cw + 2 * FF + c), z1 = *(const f32x4*)(cw + 2 * FF + c + 4), b0 = *(const f32x4*)(cb + c), b1 = *(const f32x4*)(cb + c + 4);
#pragma unroll
          for (int e = 0; e < 4; ++e) { w0[e] = x0[e]; w0[e + 4] = x1[e]; w1[e] = y0[e]; w1[e + 4] = y1[e]; w2[e] = z0[e]; w2[e + 4] = z1[e]; bb[e] = b0[e]; bb[e + 4] = b1[e]; } }
        float r[8];
#pragma unroll
        for (int e = 0; e < 4; ++e) {
            const unsigned cm = gm[e], cc = gc[e], cn = gn[e], cu = uu[e];
            const float g0 = w0[2 * e] * bflo(cm) + w1[2 * e] * bflo(cc) + w2[2 * e] * bflo(cn) + bb[2 * e];
            const float g1 = w0[2 * e + 1] * bfhi(cm) + w1[2 * e + 1] * bfhi(cc) + w2[2 * e + 1] * bfhi(cn) + bb[2 * e + 1];
            r[2 * e] = gelu_tanh(g0) * bflo(cu); r[2 * e + 1] = gelu_tanh(g1) * bfhi(cu);
        }
        u32x4 w = {pk2(r[0], r[1]), pk2(r[2], r[3]), pk2(r[4], r[5]), pk2(r[6], r[7])};
        *(u32x4*)(gp + 4096) = w;
    }
}


#define XB_TMO      128
#define XB_XCNT(j)  (256  + 64 * (j))
#define XB_XSUB(j)  (1280 + 64 * (j))
#define XB_XGEN(j)  (2304 + 64 * (j))
#define XB_TOP      3328
#define XB_TOPGEN   3392
#define XCD_BAR_WORDS 3456
#define XB_SPIN_CAP (1u << 20)
__device__ __forceinline__ unsigned xb_ld(unsigned* p)              { return __hip_atomic_load(p, __ATOMIC_RELAXED, __HIP_MEMORY_SCOPE_AGENT); }
__device__ __forceinline__ unsigned xb_add(unsigned* p, unsigned v) { return __hip_atomic_fetch_add(p, v, __ATOMIC_RELAXED, __HIP_MEMORY_SCOPE_AGENT); }
__device__ __forceinline__ unsigned xb_xcc_id() { return (unsigned)__builtin_amdgcn_s_getreg((3 << 11) | 20) & 0xFu; }
#define XB_SPIN(cond, bar) do { unsigned _sp = 0; while (cond) { __builtin_amdgcn_s_sleep(1); \
    if ((++_sp & 255u) == 0u) { if (xb_ld(&(bar)[XB_TMO])) break; if (_sp > XB_SPIN_CAP) { atomicAdd(&(bar)[XB_TMO], 1u); break; } } } } while (0)
struct XcdBarrier { unsigned* bar; unsigned x; volatile LAS unsigned* st; };
__device__ __forceinline__ XcdBarrier xcd_barrier_post(unsigned* bar, volatile LAS unsigned* st) {
    XcdBarrier b; b.bar = bar; b.x = xb_xcc_id(); b.st = st;
    if (threadIdx.x == 0) (void)xb_add(&bar[XB_XCNT(b.x)], 1u);
    return b;
}
__device__ __forceinline__ void xcd_barrier_complete(unsigned* bar, unsigned x, unsigned& nloc, unsigned& nx) {
    const unsigned G = gridDim.x * gridDim.y * gridDim.z;
    unsigned sum, cnt, mine, sp = 0u;
    for (;;) {
        sum = 0u; cnt = 0u; mine = 0u;
#pragma unroll
        for (unsigned j = 0; j < 16; ++j) { const unsigned c = xb_ld(&bar[XB_XCNT(j)]); sum += c; cnt += (c > 0u) ? 1u : 0u; mine = (j == x) ? c : mine; }
        if (sum == G) break;
        __builtin_amdgcn_s_sleep(1);
        if ((++sp & 255u) == 0u) { if (xb_ld(&bar[XB_TMO])) break; if (sp > XB_SPIN_CAP) { atomicAdd(&bar[XB_TMO], 1u); break; } }
    }
    nloc = mine > 0u ? mine : 1u; nx = cnt > 0u ? cnt : 1u;
}
__device__ __forceinline__ void xcd_barrier(const XcdBarrier& b) {
    asm volatile("s_waitcnt vmcnt(0)" ::: "memory");
    __syncthreads();
    if (threadIdx.x == 0) {
        unsigned* bar = b.bar;
        __builtin_amdgcn_s_waitcnt(0);
        unsigned nloc = b.st[0], nx = b.st[1];
        if (nloc == 0u) { xcd_barrier_complete(bar, b.x, nloc, nx); b.st[0] = nloc; b.st[1] = nx; }
        const unsigned old = xb_add(&bar[XB_XSUB(b.x)], 1u);
        const unsigned gen = old / nloc;
        if (old + 1u == (gen + 1u) * nloc) {
            __builtin_amdgcn_fence(__ATOMIC_RELEASE, "agent");
            asm volatile("s_waitcnt vmcnt(0)" ::: "memory");
            const unsigned og = xb_add(&bar[XB_TOP], 1u);
            const unsigned tg = og / nx;
            if (og + 1u == (tg + 1u) * nx) xb_add(&bar[XB_TOPGEN], 1u);
            else XB_SPIN(xb_ld(&bar[XB_TOPGEN]) == tg, bar);
            __builtin_amdgcn_fence(__ATOMIC_ACQUIRE, "agent");
            xb_add(&bar[XB_XGEN(b.x)], 1u);
            asm volatile("s_waitcnt vmcnt(0)" ::: "memory");
        } else {
            XB_SPIN(xb_ld(&bar[XB_XGEN(b.x)]) == gen, bar);
            __builtin_amdgcn_fence(__ATOMIC_ACQUIRE, "agent");
            asm volatile("s_waitcnt vmcnt(0)" ::: "memory");
        }
    }
    __syncthreads();
}

enum { OP_NONE = 0, OP_GEMM, OP_MLAC, OP_GQAC, OP_ATT_MLA, OP_ATT_GQA, OP_ATT_NA, OP_ROW, OP_ACT };

__global__ void __launch_bounds__(512) fwd_mega(Args a_kernarg) {
    extern __shared__ __attribute__((aligned(16))) unsigned char lds_raw[];
    cg::grid_group grid = cg::this_grid();
    LAS unsigned char* lds = (LAS unsigned char*)lds_raw;
    const int G = gridDim.x, bx = blockIdx.x;
    const int vcu = (G % 8 == 0) ? (bx % 8) * (G / 8) + bx / 8 : bx;
    const int NGW = G * 8, ngt = G * 512;
#define LAUNDER_TID() CArgs a = (CArgs)__builtin_amdgcn_kernarg_segment_ptr(); asm volatile("" : "+s"(a)); int tl_ = threadIdx.x; asm volatile("" : "+v"(tl_)); const int tid = tl_, lane = tid & 63, wave = __builtin_amdgcn_readfirstlane(tid >> 6); const int gw = vcu * 8 + wave, gtid = bx * 512 + tid
    unsigned char* ws = a_kernarg.ws;
    if (threadIdx.x < 2) ((volatile LAS unsigned*)(lds + LDS_MISC))[threadIdx.x] = 0u;
    __syncthreads();
    const XcdBarrier xbar = xcd_barrier_post((unsigned*)ws, (volatile LAS unsigned*)(lds + LDS_MISC));
    float* COS = (float*)(ws + WS_COS); float* SIN = (float*)(ws + WS_SIN);
    bf16_t* HN = (bf16_t*)(ws + WS_HN); bf16_t* PB = (bf16_t*)(ws + WS_PB);
    unsigned char* R = ws + WS_R; unsigned char* WB = ws + WS_WB;

    {
    LAUNDER_TID();
    for (int i = gtid; i < 8192 * 32; i += ngt) {
        const int pos = i >> 5, f = i & 31;
        double inv = 1.0; for (int k = 0; k < f; ++k) inv *= 0.74989420933245582730;
        const double rev = (double)pos * inv * 0.15915494309189535;
        const double fr = rev - __builtin_rint(rev);
        const float ff = (float)fr;
        COS[i] = __builtin_amdgcn_cosf(ff); SIN[i] = __builtin_amdgcn_sinf(ff);
    }
#if EN_INIT
    conv_layer(a, 0, lds, gw, NGW, lane, wave, gtid, ngt);
#endif
    rowpass(a, gw, NGW, lane, true, nullptr, nullptr, true, a->in[4], HN);
    }
    if (G > (1 << 24)) grid.sync();
    xcd_barrier(xbar);

    for (int L = 0; L < 4; ++L) {
        const int kind = L % 3, jl = L / 3;
        for (int s = 0; s < 17; ++s) {
            LAUNDER_TID();
            int op = OP_NONE; bool sync = true;
            pg8::Gemm gj{nullptr, nullptr, NTOK, 0, 0, 0, 0}; pg8::Epi ep{nullptr, 0, nullptr, 0, nullptr, nullptr, (LAS float*)(lds + 131072)};
            const bf16_t* rsrc = nullptr; const float* rgadd = nullptr; const float* rgout = nullptr; bool rhas = true; int hh = 0;
            switch (s) {
            case 0: op = OP_GEMM; gj.A = HN; gj.lda = DM; gj.Bt = (const bf16_t*)(WB + WB_MIX1); gj.K = DM;
                    if (kind == 0) { gj.N = 768; ep.O = (bf16_t*)(R + R_DOWN); } else if (kind == 1) { gj.N = 1536; ep.O = (bf16_t*)(R + R_Q); } else { gj.N = 3072; ep.O = (bf16_t*)(R + R_Q); }
                    ep.ldc = gj.N; break;
            case 1: if (kind == 0) op = OP_MLAC; else if (kind == 1) op = OP_GQAC; else sync = false; break;
            case 2: sync = false; if (kind == 0) { op = OP_GEMM; gj.A = (const bf16_t*)(R + R_CQ); gj.lda = 384; gj.Bt = (const bf16_t*)(WB + WB_UQ); gj.N = 1536; gj.K = 384; ep.O = (bf16_t*)(R + R_Q); ep.ldc = 1536; } break;
            case 3: if (kind == 0) { op = OP_GEMM; gj.A = (const bf16_t*)(R + R_CKV); gj.lda = 256; gj.Bt = (const bf16_t*)(WB + WB_UKV); gj.N = 2048; gj.K = 256; ep.O = (bf16_t*)(R + R_KV); ep.ldc = 2048; } else sync = false; break;
            case 4: op = kind == 0 ? OP_ATT_MLA : (kind == 1 ? OP_ATT_GQA : OP_ATT_NA); break;
            case 5: op = OP_GEMM; gj.A = (const bf16_t*)(R + R_O); gj.lda = DM; gj.Bt = (const bf16_t*)(WB + WB_O); gj.N = DM; gj.K = DM; ep.O = HN; ep.ldc = DM; break;
            case 6: op = OP_ROW; rsrc = HN; rgadd = a->in[5] + L * DM; rgout = a->in[6] + L * DM; break;
            case 7: op = OP_GEMM; gj.A = HN; gj.lda = DM; gj.Bt = (const bf16_t*)(WB + WB_IN); gj.M = 130 * 256; gj.N = 2 * FF; gj.K = DM; gj.ffn = 1;
                    ep.O = (bf16_t*)(R + R_GU); ep.ldc = FF; ep.mode = 2; ep.cw = a->in[22] + (size_t)L * 3 * FF; ep.cb = a->in[23] + (size_t)L * FF; break;
            case 9: op = OP_GEMM; gj.A = (const bf16_t*)(R + R_GU); gj.lda = FF; gj.Bt = (const bf16_t*)(WB + WB_OUT); gj.N = DM; gj.K = FF; ep.O = HN; ep.ldc = DM; break;
            case 8: sync = false; op = OP_GEMM; gj.A = PB; gj.lda = PLE; gj.Bt = (const bf16_t*)(WB + WB_PROJ); gj.N = DM; gj.K = PLE; ep.O = (bf16_t*)(ws + WS_E); ep.ldc = DM; break;
            case 10: case 11: case 12: case 14: sync = false; break;
            case 13: op = OP_ROW; rsrc = HN; rgadd = a->in[7] + L * DM; rgout = nullptr; break;
            case 15: op = OP_GEMM; gj.A = HN; gj.lda = DM; gj.Bt = (const bf16_t*)(WB + WB_GATE); gj.N = DM; gj.K = DM; ep.O = (bf16_t*)(R + R_GE); ep.ldc = DM; ep.E = (const bf16_t*)(ws + WS_E); ep.mode = 1; break;
            default: op = OP_ROW; rsrc = (const bf16_t*)(R + R_GE); rgadd = a->in[27] + L * DM; if (L < 3) rgout = a->in[4] + (L + 1) * DM; else { rhas = false; sync = false; } break;
            }
            if (op == OP_GEMM) {
                pg8::StaticOrder S; S.init(gj.M, gj.N, G, bx);
#if EN_GEMM
                pg8::gemm_phase(lds, gj, S, ep, tid);
#endif
            } else if (op == OP_ROW) {
#if EN_ROW
                rowpass(a, gw, NGW, lane, false, rsrc, rgadd, rhas, rgout, HN);
                if (s == 16 && L < 3) conv_layer(a, L + 1, lds, gw, NGW, lane, wave, gtid, ngt);
#endif
            } else if (op == OP_ACT) {
#if EN_ACT
                act_pass(a, L, hh, gtid, ngt);
#endif
            } else if (op == OP_MLAC) {
#if EN_MLAC
                mla_c(a, jl, gw, NGW, lane);
#endif
            } else if (op == OP_GQAC) {
#if EN_GQAC
                gqa_c(a, jl, gw, NGW, lane);
#endif
            } else if (op == OP_ATT_MLA) {
                const bf16_t* Q = (const bf16_t*)(R + R_Q); const bf16_t* KV = (const bf16_t*)(R + R_KV); const bf16_t* KR = (const bf16_t*)(R + R_KROPE); bf16_t* O = (bf16_t*)(R + R_O);
                unsigned* ctr = (unsigned*)ws + XCD_BAR_WORDS + 64 * (L + 1);
                volatile LAS unsigned* uw = (volatile LAS unsigned*)(lds + LDS_MISC + 16);
                int uu = vcu; bool dyn = false;
                for (;;) {
                    if (!dyn && uu >= 512) dyn = true;
                    if (dyn) { if (tid == 0) uw[0] = 512u + atomicAdd(ctr, 1u); __syncthreads(); uu = __builtin_amdgcn_readfirstlane((int)uw[0]); __syncthreads(); if (uu >= 1024) break; }
                    int rowbase, seq, qb, h;
                    if (uu < 512) { qb = uu & 31; h = (uu >> 5) & 7; rowbase = HTOK + (uu >> 8) * 8192; seq = 8192; }
                    else { const int u = uu - 512; qb = u & 7; h = (u >> 3) & 7; rowbase = (u >> 6) * 2048; seq = 2048; }
                    const bf16_t* Kh = KV + (size_t)rowbase * 2048 + h * 256;
#if EN_AMLA
                    att::attn_unit<192, 2048>(Q + (size_t)(rowbase + qb * 256) * 1536 + h * 192, Kh, Kh + 128, KR + (size_t)rowbase * 64,
                                              O + (size_t)(rowbase + qb * 256) * 1024 + h * 128, seq, qb * 256, COS, SIN, (char*)lds_raw);
#endif
                    if (!dyn) uu += G;
                }
            } else if (op == OP_ATT_GQA) {
                const bf16_t* QKV = (const bf16_t*)(R + R_Q); bf16_t* O = (bf16_t*)(R + R_O);
                unsigned* ctr = (unsigned*)ws + XCD_BAR_WORDS + 64 * (L + 1);
                volatile LAS unsigned* uw = (volatile LAS unsigned*)(lds + LDS_MISC + 16);
                int uu = vcu; bool dyn = false;
                for (;;) {
                    if (!dyn && uu >= 512) dyn = true;
                    if (dyn) { if (tid == 0) uw[0] = 512u + atomicAdd(ctr, 1u); __syncthreads(); uu = __builtin_amdgcn_readfirstlane((int)uw[0]); __syncthreads(); if (uu >= 1024) break; }
                    int rowbase, seq, qb, h;
                    if (uu < 512) { qb = uu & 31; h = (uu >> 5) & 7; rowbase = HTOK + (uu >> 8) * 8192; seq = 8192; }
                    else { const int u = uu - 512; qb = u & 7; h = (u >> 3) & 7; rowbase = (u >> 6) * 2048; seq = 2048; }
                    const bf16_t* Kh = QKV + (size_t)rowbase * 1536 + 1024 + (h >> 2) * 128;
#if EN_AGQA
                    att::attn_unit<128, 1536>(QKV + (size_t)(rowbase + qb * 256) * 1536 + h * 128, Kh, Kh + 256, nullptr,
                                              O + (size_t)(rowbase + qb * 256) * 1024 + h * 128, seq, qb * 256, COS, SIN, (char*)lds_raw);
#endif
                    if (!dyn) uu += G;
                }
            } else if (op == OP_ATT_NA) {
                const bf16_t* QKV = (const bf16_t*)(R + R_Q); bf16_t* O = (bf16_t*)(R + R_O);
                const float* rpb = a->in[19] + (size_t)jl * 16 * 15 * 31;
                for (int uu = vcu; uu < 2048; uu += G) {
                    int tok0, rows, g4, h;
                    if (uu < 1024) { h = uu & 15; g4 = (uu >> 4) & 7; tok0 = (uu >> 7) * 2048; rows = 32; }
                    else { const int u = uu - 1024; h = u & 15; g4 = (u >> 4) & 31; tok0 = HTOK + (u >> 9) * 8192; rows = 128; }
#if EN_NA
                    na2::na_unit(QKV, O, rpb, tok0, rows, g4, h, (char*)lds_raw);
#endif
                }
            }
            (void)sync;
            {
                int s2 = s; asm volatile("" : "+s"(s2));
                const bool need = (s2 == 1) ? (kind != 2) : (s2 == 3) ? (kind == 0) : (s2 == 16) ? (L < 3) : !(s2 == 2 || s2 == 8 || (s2 >= 10 && s2 <= 12) || s2 == 14);
                if (need) xcd_barrier(xbar);
            }
        }
    }
}

extern "C" void kernel_launch(void* const* d_in, const int* in_sizes, int n_in, void* d_out, int out_size, void* d_ws, size_t ws_size, hipStream_t stream) {
    static int grid = 0;
    if (grid == 0) {
        if (n_in != 28 || out_size != NTOK * DM || ws_size < WS_END) { fprintf(stderr, "kernel_launch: unexpected shapes (n_in %d out %d ws %zu need %zu)\n", n_in, out_size, ws_size, (size_t)WS_END); grid = -1; return; }
        int dev = 0, cus = 0, per = 0;
        (void)hipGetDevice(&dev); (void)hipDeviceGetAttribute(&cus, hipDeviceAttributeMultiprocessorCount, dev);
        (void)hipFuncSetAttribute((const void*)fwd_mega, hipFuncAttributeMaxDynamicSharedMemorySize, LDS_BYTES);
        (void)hipOccupancyMaxActiveBlocksPerMultiprocessor(&per, (const void*)fwd_mega, 512, LDS_BYTES);
        if (per < 1) per = 1;
        grid = cus * per;
        fprintf(stderr, "kernel_launch: cus %d per_cu %d grid %d ws %zu\n", cus, per, grid, ws_size);
    }
    if (grid < 0) return;
    (void)hipMemsetAsync(d_ws, 0, 16384, stream);
    Args a{};
    for (int i = 0; i < 28; ++i) a.in[i] = (const float*)d_in[i];
    a.out = (float*)d_out; a.ws = (unsigned char*)d_ws;
    void* args[] = {&a};
    hipError_t e = hipLaunchCooperativeKernel((const void*)fwd_mega, dim3(grid), dim3(512), args, LDS_BYTES, stream);
    if (e != hipSuccess) fprintf(stderr, "kernel_launch: cooperative launch failed: %s (grid %d)\n", hipGetErrorString(e), grid);
}
```
